# Optimizing an MI355X kernel written in HIP

```python
import math
import jax, jax.numpy as jnp
from jax import lax
import numpy as np

D_MODEL = 2048
BATCH = 4
SEQ = 4096
DEPTH = 1

N_META = 16
ROPE_THETA = 10000.0
NORM_EPS = 1e-6
DA_HEADS = 4
DA_HEAD_DIM = 128
DA_V_DIM = 2 * DA_HEAD_DIM
DA_Q_WIDTH = DA_HEADS * 2 * DA_HEAD_DIM
DA_V_WIDTH = DA_HEADS * DA_V_DIM
Q_BLOCK = 128
RET_HEADS = 4
RET_QK_DIM = 256
RET_V_DIM = 256
RET_QK_WIDTH = RET_HEADS * RET_QK_DIM
RET_V_WIDTH = RET_HEADS * RET_V_DIM
CHUNK = 128
D_FF = 4 * D_MODEL
IN_WIDTH = 2 * DA_Q_WIDTH + DA_V_WIDTH + 2 * RET_QK_WIDTH + 2 * RET_V_WIDTH + 2 * D_MODEL

kernel_name = 'hybrid_diffattn_retention_gated_block'


def _rms(x):
    xf = x.astype(jnp.float32)
    return xf * lax.rsqrt(jnp.mean(xf * xf, axis=-1, keepdims=True) + NORM_EPS)


def rmsnorm(x, g):
    return (_rms(x) * g.astype(jnp.float32)).astype(x.dtype)


def rope(x, pos):
    d = x.shape[-1]
    half = d // 2
    inv = ROPE_THETA ** (-jnp.arange(half, dtype=jnp.float32) / half)
    ang = pos.astype(jnp.float32)[:, None] * inv[None, :]
    cos = jnp.cos(ang).astype(x.dtype)
    sin = jnp.sin(ang).astype(x.dtype)
    x1, x2 = x[..., :half], x[..., half:]
    return jnp.concatenate([x1 * cos - x2 * sin, x2 * cos + x1 * sin], axis=-1)


def diff_attention(q, k, v, lam, lambda_init, subln_g):
    B, H, _, L, dh = q.shape
    nb = -(-L // Q_BLOCK)
    Lq = nb * Q_BLOCK
    qp = jnp.pad(q, ((0, 0), (0, 0), (0, 0), (0, Lq - L), (0, 0)))
    qb = qp.reshape(B, H, 2, nb, Q_BLOCK, dh).transpose(3, 0, 1, 2, 4, 5)
    scale = dh ** -0.5
    kpos = jnp.arange(L)

    def block(args):
        qblk, i = args
        s = jnp.einsum('bhcqd,bhckd->bhcqk', qblk, k).astype(jnp.float32) * scale
        qpos = i * Q_BLOCK + jnp.arange(Q_BLOCK)
        mask = kpos[None, :] <= qpos[:, None]
        p = jax.nn.softmax(jnp.where(mask, s, -jnp.inf), axis=-1)
        a = p[:, :, 0] - lam * p[:, :, 1]
        return jnp.einsum('bhqk,bhkd->bhqd', a.astype(v.dtype), v)

    o = lax.map(block, (qb, jnp.arange(nb)))
    o = o.transpose(1, 2, 0, 3, 4).reshape(B, H, Lq, v.shape[-1])[:, :, :L]
    return rmsnorm(o, subln_g) * (1.0 - lambda_init)


def retention(q, k, v, log_gamma):
    in_dtype = v.dtype
    q, k, v = (t.astype(jnp.float32) for t in (q, k, v))
    B, H, L, dk = q.shape
    dv = v.shape[-1]
    pad = (-L) % CHUNK
    padw = ((0, 0), (0, 0), (pad, 0), (0, 0))
    n = (L + pad) // CHUNK

    def chunks(t):
        t = jnp.pad(t, padw)
        return t.reshape(B, H, n, CHUNK, t.shape[-1]).transpose(2, 0, 1, 3, 4)

    qc, kc, vc = chunks(q), chunks(k), chunks(v)
    idx = jnp.arange(CHUNK, dtype=jnp.float32)
    lg = log_gamma[:, None, None]
    rel = idx[:, None] - idx[None, :]
    decay_mask = jnp.where(rel >= 0, jnp.exp(lg * jnp.maximum(rel, 0.0)), 0.0)
    xi = jnp.exp(log_gamma[:, None] * (idx[None, :] + 1.0))
    zeta = jnp.exp(log_gamma[:, None] * (CHUNK - 1.0 - idx[None, :]))
    chunk_decay = jnp.exp(log_gamma * CHUNK)

    def step(R, inp):
        qi, ki, vi = inp
        s = jnp.einsum('bhqd,bhkd->bhqk', qi, ki) * decay_mask
        inner = jnp.einsum('bhqk,bhkd->bhqd', s, vi)
        cross = jnp.einsum('bhqd,bhde->bhqe', qi, R) * xi[None, :, :, None]
        R = chunk_decay[None, :, None, None] * R + jnp.einsum(
            'bhkd,bhke->bhde', ki, vi * zeta[None, :, :, None])
        return R, inner + cross

    R0 = jnp.zeros((B, H, dk, dv), jnp.float32)
    _, o = lax.scan(step, R0, (qc, kc, vc))
    o = o.transpose(1, 2, 0, 3, 4).reshape(B, H, n * CHUNK, dv)[:, :, pad:]
    return o.astype(in_dtype)


def hybrid_layer(h, pos, lambda_init, norm1_g, w_in, lam_q1, lam_k1, lam_q2, lam_k2,
                 da_subln_g, w_pa, w_pr, w_o, norm2_g, w_up, w_down):
    B, L, D = h.shape
    xn = rmsnorm(h, norm1_g)
    proj = xn @ w_in
    sizes = [DA_Q_WIDTH, DA_Q_WIDTH, DA_V_WIDTH, RET_QK_WIDTH, RET_QK_WIDTH,
             RET_V_WIDTH, RET_V_WIDTH, D_MODEL, D_MODEL]
    cuts = [sum(sizes[:i + 1]) for i in range(len(sizes) - 1)]
    da_q, da_k, da_v, r_q, r_k, r_v, r_g, g_a, g_r = jnp.split(proj, cuts, axis=-1)

    q = da_q.reshape(B, L, DA_HEADS, 2, DA_HEAD_DIM).transpose(0, 2, 3, 1, 4)
    k = da_k.reshape(B, L, DA_HEADS, 2, DA_HEAD_DIM).transpose(0, 2, 3, 1, 4)
    v = da_v.reshape(B, L, DA_HEADS, DA_V_DIM).transpose(0, 2, 1, 3)
    q, k = rope(q, pos), rope(k, pos)
    lam = (jnp.exp(jnp.sum(lam_q1.astype(jnp.float32) * lam_k1.astype(jnp.float32)))
           - jnp.exp(jnp.sum(lam_q2.astype(jnp.float32) * lam_k2.astype(jnp.float32)))
           + lambda_init)
    oa = diff_attention(q, k, v, lam, lambda_init, da_subln_g)
    y_a = oa.transpose(0, 2, 1, 3).reshape(B, L, DA_V_WIDTH) @ w_pa

    rq = rope(r_q.reshape(B, L, RET_HEADS, RET_QK_DIM).transpose(0, 2, 1, 3), pos)
    rk = rope(r_k.reshape(B, L, RET_HEADS, RET_QK_DIM).transpose(0, 2, 1, 3), pos) * (RET_QK_DIM ** -0.5)
    rv = r_v.reshape(B, L, RET_HEADS, RET_V_DIM).transpose(0, 2, 1, 3)
    log_gamma = jnp.log(1.0 - 2.0 ** (-5.0 - jnp.arange(RET_HEADS, dtype=jnp.float32)))
    orr = retention(rq, rk, rv, log_gamma)
    orr = _rms(orr).astype(h.dtype)
    orr = orr.transpose(0, 2, 1, 3).reshape(B, L, RET_V_WIDTH) * jax.nn.silu(r_g)
    y_r = orr @ w_pr

    merged = jax.nn.sigmoid(g_a) * y_a + jax.nn.sigmoid(g_r) * y_r
    h = h + merged @ w_o

    hn = rmsnorm(h, norm2_g)
    h = h + jnp.square(jax.nn.relu(hn @ w_up)) @ w_down
    return h


def setup_inputs(seed: int = 0) -> dict:
    key = jax.random.key(seed)
    ks = jax.random.split(key, 16)
    f32 = jnp.float32

    def w(k, shape, fan_in):
        return jax.random.normal(k, shape, f32) * fan_in ** -0.5

    def gain(k, shape):
        return 1.0 + 0.02 * jax.random.normal(k, shape, f32)

    return {
        'x': jax.random.normal(ks[0], (BATCH, SEQ, D_MODEL), f32),
        'meta_tokens': jax.random.normal(ks[1], (N_META, D_MODEL), f32),
        'norm1_g': gain(ks[2], (DEPTH, D_MODEL)),
        'w_in': w(ks[3], (DEPTH, D_MODEL, IN_WIDTH), D_MODEL),
        'lam_q1': 0.1 * jax.random.normal(ks[4], (DEPTH, DA_HEAD_DIM), f32),
        'lam_k1': 0.1 * jax.random.normal(ks[5], (DEPTH, DA_HEAD_DIM), f32),
        'lam_q2': 0.1 * jax.random.normal(ks[6], (DEPTH, DA_HEAD_DIM), f32),
        'lam_k2': 0.1 * jax.random.normal(ks[7], (DEPTH, DA_HEAD_DIM), f32),
        'da_subln_g': gain(ks[8], (DEPTH, DA_V_DIM)),
        'w_pa': w(ks[9], (DEPTH, DA_V_WIDTH, D_MODEL), DA_V_WIDTH),
        'w_pr': w(ks[10], (DEPTH, RET_V_WIDTH, D_MODEL), RET_V_WIDTH),
        'w_o': w(ks[11], (DEPTH, D_MODEL, D_MODEL), D_MODEL),
        'norm2_g': gain(ks[12], (DEPTH, D_MODEL)),
        'w_up': w(ks[13], (DEPTH, D_MODEL, D_FF), D_MODEL),
        'w_down': w(ks[14], (DEPTH, D_FF, D_MODEL), D_FF),
        'normf_g': gain(ks[15], (D_MODEL,)),
    }


def reference(x, meta_tokens, norm1_g, w_in, lam_q1, lam_k1, lam_q2, lam_k2, da_subln_g,
              w_pa, w_pr, w_o, norm2_g, w_up, w_down, normf_g):
    B, S, D = x.shape
    meta = jnp.broadcast_to(meta_tokens.astype(x.dtype)[None], (B, N_META, D))
    h = jnp.concatenate([meta, x], axis=1)
    pos = jnp.arange(N_META + S)
    for l in range(DEPTH):
        lambda_init = 0.8 - 0.6 * math.exp(-0.3 * l)
        h = hybrid_layer(h, pos, lambda_init, norm1_g[l], w_in[l], lam_q1[l], lam_k1[l],
                         lam_q2[l], lam_k2[l], da_subln_g[l], w_pa[l], w_pr[l], w_o[l],
                         norm2_g[l], w_up[l], w_down[l])
    h = rmsnorm(h, normf_g)
    return h[:, N_META:]
```

```cpp
#include <hip/hip_runtime.h>
#include <hip/hip_bf16.h>
#include <hip/hip_cooperative_groups.h>
#include <cstdio>
#include <cstdint>
namespace cg = cooperative_groups;

constexpr int NB = 4, SEQ = 4096, DM = 2048, NMETA = 16, MTOK = NB * SEQ, INW = 11264, DFF = 8192;
constexpr int KVROWS = 4160;
constexpr int RKROWS = 4224;
constexpr float NORM_EPS = 1e-6f;
constexpr int LDS_BYTES = 147456;
constexpr int LDS_MISC = 143360;

constexpr size_t MiB = 1u << 20;
constexpr size_t SZ_QKV = (size_t)32 * KVROWS * 128 * 2;
constexpr size_t SZ_RK = (size_t)16 * RKROWS * 256 * 2;
constexpr size_t WS_CTL = 0, WS_MISC = 1 * MiB;
constexpr size_t WS_DAC = WS_MISC, WS_DAS = WS_DAC + (size_t)4112 * 64 * 4, WS_RTC = WS_DAS + (size_t)4112 * 64 * 4, WS_RTS = WS_RTC + (size_t)4112 * 128 * 4;
constexpr size_t WS_SS1 = WS_RTS + (size_t)4112 * 128 * 4, WS_SS2 = WS_SS1 + 65536, WS_XNM = WS_SS2 + 65536, WS_MISC_END = WS_XNM + 65536;
constexpr size_t WS_WCAT = 8 * MiB, WS_WO = 16 * MiB;
constexpr size_t WS_GA = 24 * MiB, WS_H1B = 24 * MiB;
constexpr size_t WS_GR = 88 * MiB, WS_WUP = 88 * MiB, WS_WDN = 120 * MiB;
constexpr size_t WS_Q = 152 * MiB, WS_K = WS_Q + SZ_QKV, WS_V = WS_K + SZ_QKV;
constexpr size_t WS_RQ = WS_V + SZ_QKV;
constexpr size_t WS_RK = WS_RQ + 32 * MiB;
constexpr size_t WS_RV = WS_RK + SZ_RK;
constexpr size_t WS_RG = WS_RV + SZ_RK;
constexpr int NBF = 6144, NF8 = INW - NBF;
constexpr size_t WS_WIN = WS_RG + 32 * MiB;
constexpr size_t WS_W8 = WS_WIN + (size_t)NBF * DM * 2;
constexpr size_t WS_XN = WS_W8 + (size_t)NF8 * DM;
constexpr size_t WS_XN8 = WS_XN + (size_t)MTOK * DM * 2;
constexpr size_t WS_X2 = WS_WIN;
constexpr size_t WS_RT = WS_X2 + 64 * MiB, WS_MERGED = WS_RT;
constexpr size_t WS_HID = 152 * MiB;
constexpr size_t WS_H2B = WS_HID + 256 * MiB;
constexpr size_t WS_END = WS_XN8 + (size_t)MTOK * DM;
static_assert(WS_MISC_END <= WS_WCAT && WS_GA + 64 * MiB == WS_GR && WS_GR + 64 * MiB == WS_Q && WS_RG == (size_t)(347.5 * 1048576.0) && WS_WIN == (size_t)(379.5 * 1048576.0) && WS_END <= 512 * MiB
              && WS_H2B + 64 * MiB <= WS_END && WS_X2 + 64 * MiB == WS_RT && WS_RT + 64 * MiB <= WS_END && WS_HID + 256 * MiB <= WS_END, "d_ws map");

typedef unsigned short bf16_t;
namespace pg8 {
#define PG8_LAS __attribute__((address_space(3)))
typedef unsigned short bf16_t;
typedef short bf16x8 __attribute__((ext_vector_type(8)));
typedef float f32x4 __attribute__((ext_vector_type(4)));
typedef unsigned u32x4 __attribute__((ext_vector_type(4)));
constexpr int BM = 256, BK = 64, HALF = 128, HTB = HALF * BK * 2  , STAGE_BYTES = 8 * HTB, NXCD = 8, WGM = 8;

__host__ __device__ __forceinline__ int lds_byte(int r, int c) { const int st = (r >> 4) * 2 + (c >> 5), rr = r & 15, cc = c & 31, ob = rr * 64 + cc * 2; return st * 1024 + (ob ^ (((ob >> 9) & 1) << 5)); }
__host__ __device__ __forceinline__ void stage_rc(int b, int& R, int& C) { const int st = b / 1024, sb = b % 1024, swz = sb ^ (((sb >> 9) & 1) << 5); R = (st >> 1) * 16 + swz / 64; C = (st & 1) * 32 + (swz % 64) / 2; }
__host__ __device__ __forceinline__ int perm32(int rho) { const int n = rho >> 4, i = rho & 15; return 8 * (i >> 2) + 4 * n + (i & 3); }

struct Unit { int pm, pn; };
struct Gemm { const bf16_t* A; const bf16_t* Bt; int M, N, K; };

struct StaticOrder {
    int nM, nN, nwg, G, c;
    __host__ __device__ void init(int M, int N, int G_, int c_) { nM = M / BM; nN = N / BM; nwg = nM * nN; G = G_; c = c_; }
    __host__ __device__ bool next(int i, Unit& u) const {
        const long L = (long)i * G + c; if (L >= nwg) return false;
        int wgid = (int)L; { const int q = nwg / NXCD, r = nwg % NXCD, xcd = wgid % NXCD, off = wgid / NXCD; wgid = (xcd < r ? xcd * (q + 1) : r * (q + 1) + (xcd - r) * q) + off; }
        const int nig = WGM * nN, gid = wgid / nig, fm = gid * WGM, gsz = (nM - fm) < WGM ? (nM - fm) : WGM;
        u.pm = fm + ((wgid % nig) % gsz); u.pn = (wgid % nig) / gsz; return true;
    }
    __device__ __forceinline__ void a_ready(const Unit&) const {}
    __device__ __forceinline__ void done(const Unit&) const {}
};

typedef int pg8_v8i __attribute__((ext_vector_type(8))); typedef int pg8_v4i __attribute__((ext_vector_type(4)));
__device__ __forceinline__ pg8_v8i pg8_cat8(bf16x8 lo, bf16x8 hi) { const pg8_v4i a = __builtin_bit_cast(pg8_v4i, lo), c = __builtin_bit_cast(pg8_v4i, hi); return __builtin_shufflevector(a, c, 0, 1, 2, 3, 4, 5, 6, 7); }
__device__ __forceinline__ void pg8_mfma8(f32x4& c, pg8_v8i a, pg8_v8i b, int sa, int sb) {
    asm volatile("v_mfma_scale_f32_16x16x128_f8f6f4 %0, %1, %2, %0, %3, %4 op_sel_hi:[0,0,0]" : "+v"(c) : "v"(a), "v"(b), "v"(sa), "v"(sb)); }
template <class Epi, class Sched, bool ALIGN_EPI = false, bool SP2 = false>
__device__ __forceinline__ void gemm_phase(PG8_LAS unsigned char* lds, const Gemm g, const Sched& S, const Epi& E) {
    int tid = threadIdx.x; asm volatile("" : "+v"(tid));
    const int wid = __builtin_amdgcn_readfirstlane(tid >> 6), lane = tid & 63, wr = wid >> 2, wc = wid & 3, fr = lane & 15, fq = lane >> 4;
    const int K = g.K, nt = K / BK;
    unsigned voffA[2], voffB[2];
#pragma unroll
    for (int i = 0; i < 2; ++i) { int R, C; stage_rc(tid * 16 + i * 8192, R, C); const int Rb = Epi::PERM ? ((R & ~31) + perm32(R & 31)) : R;
        voffA[i] = (unsigned)(R * K + C) * 2u; voffB[i] = (unsigned)(Rb * K + C) * 2u; }
    const size_t kstep = (size_t)(BK * 2);
    const size_t hstep = (size_t)HALF * K * 2;
    const size_t tstep = 2 * hstep;
    const unsigned ldsw = (unsigned)wid * 1024u;
    const int aoff = lds_byte(wr * 64 + fr, fq * 8), boff = lds_byte(wc * 32 + fr, fq * 8);
#define PG8_SA(b, h) (((b) * 2 + (h)) * HTB)
#define PG8_SB(b, h) ((4 + (b) * 2 + (h)) * HTB)
#define PG8_STAGE(bufoff, gbase, voff) do { _Pragma("unroll") for (int _i = 0; _i < 2; ++_i) \
        __builtin_amdgcn_global_load_lds((const unsigned*)((const char*)(gbase) + (voff)[_i]), (PG8_LAS unsigned*)(lds + (bufoff) + ldsw + _i * 8192), 16, 0, 0); } while (0)
#define PG8_LDA(dst, b, h) do { _Pragma("unroll") for (int m = 0; m < 4; ++m) _Pragma("unroll") for (int k = 0; k < 2; ++k) dst[m][k] = *(const PG8_LAS bf16x8*)(lds + PG8_SA(b, h) + aoff + m * 2048 + k * 1024); } while (0)
#define PG8_LDB(dst, b, h) do { _Pragma("unroll") for (int n = 0; n < 2; ++n) _Pragma("unroll") for (int k = 0; k < 2; ++k) dst[n][k] = *(const PG8_LAS bf16x8*)(lds + PG8_SB(b, h) + boff + n * 2048 + k * 1024); } while (0)
#define PG8_MMA(ai, bj, At, Bt) do { __builtin_amdgcn_s_setprio(1); \
        if constexpr (Epi::FP8) { const int sclw_ = 0x7a7a7a7a, scla_ = 0x7f7f7f7f;   \
            _Pragma("unroll") for (int m = 0; m < 4; ++m) _Pragma("unroll") for (int n = 0; n < 2; ++n) \
                pg8_mfma8(acc[ai][bj][m][n], pg8_cat8(Bt[n][0], Bt[n][1]), pg8_cat8(At[m][0], At[m][1]), sclw_, scla_); } \
        else { _Pragma("unroll") for (int m = 0; m < 4; ++m) _Pragma("unroll") for (int n = 0; n < 2; ++n) _Pragma("unroll") for (int k = 0; k < 2; ++k) \
            acc[ai][bj][m][n] = __builtin_amdgcn_mfma_f32_16x16x32_bf16(Bt[n][k], At[m][k], acc[ai][bj][m][n], 0, 0, 0); } \
        __builtin_amdgcn_s_setprio(0); } while (0)
#define PG8_WAIT_V(n) asm volatile("s_waitcnt vmcnt(" #n ")" ::: "memory")
#define PG8_WAIT_L(n) asm volatile("s_waitcnt lgkmcnt(" #n ")" ::: "memory")
#define PG8_BAR __builtin_amdgcn_s_barrier()
#define PG8_SCHED __builtin_amdgcn_sched_barrier(0)
    Unit cur, nxt; int ui = 0;
    if (!S.next(0, cur)) return;
    f32x4 acc[2][2][4][2];
#pragma unroll
    for (int a = 0; a < 2; ++a)
#pragma unroll
        for (int b = 0; b < 2; ++b)
#pragma unroll
            for (int m = 0; m < 4; ++m)
#pragma unroll
                for (int n = 0; n < 2; ++n) acc[a][b][m][n] = (f32x4){0.f, 0.f, 0.f, 0.f};
    bf16x8 At[4][2], B0[2][2], B1[2][2];
    const char* cA = (const char*)g.A + (size_t)cur.pm * tstep; const char* cB = (const char*)g.Bt + (size_t)cur.pn * tstep;
    S.a_ready(cur);
    if constexpr (SP2) {
        PG8_STAGE(PG8_SB(0, 0), cB, voffB); PG8_STAGE(PG8_SB(0, 1), cB + hstep, voffB); PG8_STAGE(PG8_SA(0, 0), cA, voffA); PG8_STAGE(PG8_SA(0, 1), cA + hstep, voffA);
        if (wr == 1) PG8_BAR;
        PG8_WAIT_V(2); PG8_BAR;
        PG8_STAGE(PG8_SB(1, 0), cB + kstep, voffB); PG8_STAGE(PG8_SA(1, 0), cA + kstep, voffA); PG8_STAGE(PG8_SB(1, 1), cB + hstep + kstep, voffB);
        PG8_WAIT_V(6); PG8_BAR;
    } else {
        PG8_STAGE(PG8_SB(0, 0), cB, voffB); PG8_STAGE(PG8_SA(0, 0), cA, voffA); PG8_STAGE(PG8_SB(0, 1), cB + hstep, voffB); PG8_STAGE(PG8_SA(0, 1), cA + hstep, voffA);
        if (wr == 1) PG8_BAR;
        PG8_WAIT_V(4); PG8_BAR;
        PG8_STAGE(PG8_SB(1, 0), cB + kstep, voffB); PG8_STAGE(PG8_SA(1, 0), cA + kstep, voffA); PG8_STAGE(PG8_SB(1, 1), cB + hstep + kstep, voffB);
        PG8_WAIT_V(6); PG8_BAR;
    }
    for (;;) {
        const bool has_next = S.next(ui + 1, nxt);
        const char* nA = has_next ? (const char*)g.A + (size_t)nxt.pm * tstep : cA; const char* nB = has_next ? (const char*)g.Bt + (size_t)nxt.pn * tstep : cB;
        for (int t = 0; t < nt; t += 2) {
            if constexpr (Epi::MIDHOOK) { if (t == (nt >> 1)) E.mid(acc, cur, wr, wc, fr, fq); }
            const bool last = (t == nt - 2);
            const char* a1 = cA + (size_t)(t + 1) * kstep;
            const char* a2 = last ? nA : cA + (size_t)(t + 2) * kstep; const char* b2 = last ? nB : cB + (size_t)(t + 2) * kstep;
            const char* a3 = a2 + kstep; const char* b3 = b2 + kstep;
            if (last && has_next) S.a_ready(nxt);
            if constexpr (SP2) {
            PG8_LDB(B0, 0, 0); PG8_LDB(B1, 0, 1); PG8_SCHED; PG8_LDA(At, 0, 0); PG8_STAGE(PG8_SA(1, 1), a1 + hstep, voffA);
            PG8_WAIT_V(8); PG8_WAIT_L(0); PG8_BAR; PG8_MMA(0, 0, At, B0); PG8_MMA(0, 1, At, B1); PG8_BAR; PG8_SCHED;
            PG8_LDA(At, 0, 1); PG8_STAGE(PG8_SB(0, 0), b2, voffB); PG8_STAGE(PG8_SB(0, 1), b2 + hstep, voffB); PG8_STAGE(PG8_SA(0, 0), a2, voffA);
            PG8_WAIT_V(8); PG8_WAIT_L(0); PG8_BAR; PG8_MMA(1, 0, At, B0); PG8_MMA(1, 1, At, B1); PG8_BAR; PG8_SCHED;
            PG8_LDB(B0, 1, 0); PG8_LDB(B1, 1, 1); PG8_SCHED; PG8_LDA(At, 1, 0); PG8_STAGE(PG8_SA(0, 1), a2 + hstep, voffA);
            PG8_WAIT_V(8); PG8_WAIT_L(0); PG8_BAR; PG8_MMA(0, 0, At, B0); PG8_MMA(0, 1, At, B1); PG8_BAR; PG8_SCHED;
            PG8_LDA(At, 1, 1); PG8_STAGE(PG8_SB(1, 0), b3, voffB); PG8_STAGE(PG8_SB(1, 1), b3 + hstep, voffB); PG8_STAGE(PG8_SA(1, 0), a3, voffA);
            PG8_WAIT_V(8); PG8_WAIT_L(0); PG8_BAR; PG8_MMA(1, 0, At, B0); PG8_MMA(1, 1, At, B1); PG8_BAR; PG8_SCHED;
            } else {
            PG8_LDB(B0, 0, 0); PG8_SCHED; PG8_LDA(At, 0, 0); PG8_STAGE(PG8_SA(1, 1), a1 + hstep, voffA);
            PG8_WAIT_L(8); PG8_BAR; PG8_WAIT_L(0); PG8_MMA(0, 0, At, B0); PG8_BAR; PG8_SCHED;
            PG8_LDB(B1, 0, 1); PG8_STAGE(PG8_SB(0, 0), b2, voffB);
            PG8_BAR; PG8_WAIT_L(0); PG8_MMA(0, 1, At, B1); PG8_BAR;
            PG8_LDA(At, 0, 1); PG8_STAGE(PG8_SA(0, 0), a2, voffA);
            PG8_BAR; PG8_WAIT_L(0); PG8_MMA(1, 0, At, B0); PG8_BAR; PG8_SCHED;
            PG8_STAGE(PG8_SB(0, 1), b2 + hstep, voffB);
            PG8_WAIT_V(6); PG8_BAR; PG8_MMA(1, 1, At, B1); PG8_BAR;
            PG8_LDB(B0, 1, 0); PG8_SCHED; PG8_LDA(At, 1, 0); PG8_STAGE(PG8_SA(0, 1), a2 + hstep, voffA);
            PG8_WAIT_L(8); PG8_BAR; PG8_WAIT_L(0); PG8_MMA(0, 0, At, B0); PG8_BAR; PG8_SCHED;
            PG8_LDB(B1, 1, 1); PG8_STAGE(PG8_SB(1, 0), b3, voffB);
            PG8_BAR; PG8_WAIT_L(0); PG8_MMA(0, 1, At, B1); PG8_BAR;
            PG8_LDA(At, 1, 1); PG8_STAGE(PG8_SA(1, 0), a3, voffA);
            PG8_BAR; PG8_WAIT_L(0); PG8_MMA(1, 0, At, B0); PG8_BAR; PG8_SCHED;
            PG8_STAGE(PG8_SB(1, 1), b3 + hstep, voffB);
            PG8_WAIT_V(6); PG8_BAR; PG8_MMA(1, 1, At, B1); PG8_BAR;
            }
        }
        if constexpr (ALIGN_EPI) { if (wr == 0) PG8_BAR; }
        if constexpr (Epi::FP8) asm volatile("s_nop 15\n\ts_nop 15");
        if constexpr (!Epi::AFTER_DRAIN) { E(acc, cur, wr, wc, fr, fq); S.done(cur); }
        if (!has_next) break;
#pragma unroll
        for (int a = 0; a < 2; ++a)
#pragma unroll
            for (int b = 0; b < 2; ++b)
#pragma unroll
                for (int m = 0; m < 4; ++m)
#pragma unroll
                    for (int n = 0; n < 2; ++n) acc[a][b][m][n] = (f32x4){0.f, 0.f, 0.f, 0.f};
        cur = nxt; cA = nA; cB = nB; ++ui;
        if constexpr (ALIGN_EPI) { if (wr == 1) PG8_BAR; }
    }
    PG8_WAIT_V(0);
    if constexpr (!ALIGN_EPI) { if (wr == 0) PG8_BAR; }
    PG8_BAR;
    if constexpr (Epi::AFTER_DRAIN) { E.fused(acc, cur, wr, wc, fr, fq, lds, wid, lane); S.done(cur); }
#undef PG8_SA
#undef PG8_SB
#undef PG8_STAGE
#undef PG8_LDA
#undef PG8_LDB
#undef PG8_MMA
#undef PG8_WAIT_V
#undef PG8_WAIT_L
#undef PG8_BAR
#undef PG8_SCHED
}
}
namespace pg8 {
__device__ __forceinline__ unsigned cvt_pk_bf16(float lo, float hi) { typedef __bf16 cvb2_t __attribute__((ext_vector_type(2))); typedef float cvf2_t __attribute__((ext_vector_type(2))); const cvf2_t v_ = {lo, hi}; return __builtin_bit_cast(unsigned, __builtin_convertvector(v_, cvb2_t)); }
__device__ __forceinline__ u32x4 pack8f(f32x4 a, f32x4 b) { u32x4 w; w.x = cvt_pk_bf16(a[0], a[1]); w.y = cvt_pk_bf16(a[2], a[3]); w.z = cvt_pk_bf16(b[0], b[1]); w.w = cvt_pk_bf16(b[2], b[3]); return w; }
__device__ __forceinline__ void unpack8(u32x4 w, f32x4& a, f32x4& b) {
    a[0] = __uint_as_float(w.x << 16); a[1] = __uint_as_float(w.x & 0xffff0000u); a[2] = __uint_as_float(w.y << 16); a[3] = __uint_as_float(w.y & 0xffff0000u);
    b[0] = __uint_as_float(w.z << 16); b[1] = __uint_as_float(w.z & 0xffff0000u); b[2] = __uint_as_float(w.w << 16); b[3] = __uint_as_float(w.w & 0xffff0000u); }
__device__ __forceinline__ float sigm(float x) { return __builtin_amdgcn_rcpf(1.f + __builtin_amdgcn_exp2f(-1.4426950408889634f * x)); }
__device__ __forceinline__ f32x4 opq4(f32x4 v) { asm volatile("" : "+v"(v)); return v; }
__device__ __forceinline__ f32x4 sigm4(f32x4 v) { f32x4 o; o[0] = sigm(v[0]); o[1] = sigm(v[1]); o[2] = sigm(v[2]); o[3] = sigm(v[3]); return o; }
#define EPI_ENTER() asm volatile("" : "+v"(fr), "+v"(fq)); const int rowb = u.pm * BM + wr * 64 + fr
#define EPI_BATCH(ai, mp) int rb_ = rowb + (ai) * HALF + (mp) * 32; asm volatile("" : "+v"(rb_))
#define EPI_FOR_BATCH _Pragma("unroll") for (int ai = 0; ai < 2; ++ai) _Pragma("unroll") for (int mp = 0; mp < 2; ++mp)
#define EPI_FENCE() asm volatile("" ::: "memory")

struct EpiProj {
    static constexpr bool PERM = true, AFTER_DRAIN = false, MIDHOOK = false, FP8 = false;
    unsigned char* ws;
    __device__ __forceinline__ void operator()(const f32x4 (&acc)[2][2][4][2], const Unit& u, int wr, int wc, int fr, int fq) const {
        EPI_ENTER(); const int pn = u.pn, cw = wc * 32 + 8 * fq;
        if (pn < 8) {
            bf16_t* base = (bf16_t*)(ws + (pn < 4 ? WS_Q : WS_K)); const int h = pn & 3; const float* daC = (const float*)(ws + WS_DAC); const float* daS = (const float*)(ws + WS_DAS);
            const int toff = 16 * wc + 4 * fq; f32x4 cn[2], sn[2];
#define EPJ_QK_LD(ai_, mp_) do { int rq_ = rowb + (ai_) * HALF + (mp_) * 32; asm volatile("" : "+v"(rq_)); _Pragma("unroll") for (int k = 0; k < 2; ++k) { const int pq_ = 16 + ((rq_ + 16 * k) & 4095); \
                cn[k] = *(const f32x4*)(daC + pq_ * 64 + toff); sn[k] = *(const f32x4*)(daS + pq_ * 64 + toff); } } while (0)
            EPJ_QK_LD(0, 0);
            EPI_FOR_BATCH { EPI_BATCH(ai, mp); f32x4 c[2], s[2]; int pos[2], b[2];
#pragma unroll
                for (int k = 0; k < 2; ++k) { const int row = rb_ + 16 * k; b[k] = row >> 12; pos[k] = 16 + (row & 4095); c[k] = cn[k]; s[k] = sn[k]; }
                if (ai * 2 + mp < 3) EPJ_QK_LD((ai * 2 + mp + 1) >> 1, (ai * 2 + mp + 1) & 1);
#pragma unroll
                for (int k = 0; k < 2; ++k)
#pragma unroll
                    for (int bj = 0; bj < 2; ++bj) { const f32x4 x1 = acc[ai][bj][2 * mp + k][0], x2 = acc[ai][bj][2 * mp + k][1];
                        *(u32x4*)(base + ((size_t)((b[k] * 4 + h) * 2 + bj) * KVROWS + pos[k]) * 128 + cw) = pack8f(x1 * c[k] - x2 * s[k], x2 * c[k] + x1 * s[k]); }
                EPI_FENCE(); }
#undef EPJ_QK_LD
        } else if (pn < 12) {
            const int h = pn - 8; bf16_t* V = (bf16_t*)(ws + WS_V);
            EPI_FOR_BATCH { EPI_BATCH(ai, mp);
#pragma unroll
                for (int k = 0; k < 2; ++k) { const int row = rb_ + 16 * k, b = row >> 12, pos = 16 + (row & 4095);
#pragma unroll
                    for (int bj = 0; bj < 2; ++bj) *(u32x4*)(V + ((size_t)((b * 4 + h) * 2 + bj) * KVROWS + pos) * 128 + cw) = pack8f(acc[ai][bj][2 * mp + k][0], acc[ai][bj][2 * mp + k][1]); }
                EPI_FENCE(); }
        } else if (pn < 20) {
            const bool isk = pn >= 16; const int h = pn & 3; const float sc = isk ? 0.0625f : 1.f; bf16_t* RK = (bf16_t*)(ws + WS_RK); bf16_t* RQ = (bf16_t*)(ws + WS_RQ); const float* rtC = (const float*)(ws + WS_RTC); const float* rtS = (const float*)(ws + WS_RTS);
            f32x4 cn[2][2], sn[2][2];
#define EPJ_R_LD(ai_, mp_) do { int rq_ = rowb + (ai_) * HALF + (mp_) * 32; asm volatile("" : "+v"(rq_)); _Pragma("unroll") for (int k = 0; k < 2; ++k) { const int pq_ = 16 + ((rq_ + 16 * k) & 4095); \
                _Pragma("unroll") for (int bj = 0; bj < 2; ++bj) { const int d0 = 64 * bj + 16 * wc + 4 * fq; cn[k][bj] = *(const f32x4*)(rtC + pq_ * 128 + d0); sn[k][bj] = *(const f32x4*)(rtS + pq_ * 128 + d0); } } } while (0)
            EPJ_R_LD(0, 0);
            EPI_FOR_BATCH { EPI_BATCH(ai, mp); f32x4 c[2][2], s[2][2]; bf16_t* dst[2];
#pragma unroll
                for (int k = 0; k < 2; ++k) { const int row = rb_ + 16 * k, b = row >> 12, t = row & 4095;
                    dst[k] = isk ? RK + ((size_t)(b * 4 + h) * RKROWS + 128 + t) * 256 + cw : RQ + ((size_t)(b * 4 + h) * 4096 + t) * 256 + cw;
#pragma unroll
                    for (int bj = 0; bj < 2; ++bj) { c[k][bj] = cn[k][bj]; s[k][bj] = sn[k][bj]; } }
                if (ai * 2 + mp < 3) EPJ_R_LD((ai * 2 + mp + 1) >> 1, (ai * 2 + mp + 1) & 1);
#pragma unroll
                for (int k = 0; k < 2; ++k)
#pragma unroll
                    for (int bj = 0; bj < 2; ++bj) { const f32x4 x1 = acc[ai][bj][2 * mp + k][0] * sc, x2 = acc[ai][bj][2 * mp + k][1] * sc;
                        *(u32x4*)(dst[k] + bj * HALF) = pack8f(x1 * c[k][bj] - x2 * s[k][bj], x2 * c[k][bj] + x1 * s[k][bj]); }
                EPI_FENCE(); }
#undef EPJ_R_LD
        } else if (pn < 24) {
            const int h = pn - 20; bf16_t* RV = (bf16_t*)(ws + WS_RV);
            EPI_FOR_BATCH { EPI_BATCH(ai, mp);
#pragma unroll
                for (int k = 0; k < 2; ++k) { const int row = rb_ + 16 * k, b = row >> 12, t = row & 4095;
#pragma unroll
                    for (int bj = 0; bj < 2; ++bj) *(u32x4*)(RV + ((size_t)(b * 4 + h) * RKROWS + 128 + t) * 256 + bj * HALF + cw) = pack8f(acc[ai][bj][2 * mp + k][0], acc[ai][bj][2 * mp + k][1]); }
                EPI_FENCE(); }
        }
    }
};
struct EpiGateSig {
    static constexpr bool PERM = true, AFTER_DRAIN = false, MIDHOOK = false, FP8 = true;
    unsigned char* ws;
    __device__ __forceinline__ void operator()(const f32x4 (&acc)[2][2][4][2], const Unit& u, int wr, int wc, int fr, int fq) const {
        EPI_ENTER(); const int pn = u.pn, cw = wc * 32 + 8 * fq;
        if (pn < 4) {
            bf16_t* RG = (bf16_t*)(ws + WS_RG);
            EPI_FOR_BATCH { EPI_BATCH(ai, mp);
#pragma unroll
                for (int k = 0; k < 2; ++k) { const int row = rb_ + 16 * k;
#pragma unroll
                    for (int bj = 0; bj < 2; ++bj) { const f32x4 a = opq4(acc[ai][bj][2 * mp + k][0]), b2 = opq4(acc[ai][bj][2 * mp + k][1]);
                        *(u32x4*)(RG + (size_t)row * 1024 + pn * 256 + bj * HALF + cw) = pack8f(a * sigm4(a), b2 * sigm4(b2)); } }
                EPI_FENCE(); }
        } else {
            const bool isa = pn < 12; bf16_t* base = (bf16_t*)(ws + (isa ? WS_GA : WS_GR)); const int ct = ((pn - 4) & 7) * 256;
            EPI_FOR_BATCH { EPI_BATCH(ai, mp);
#pragma unroll
                for (int k = 0; k < 2; ++k) { const int row = rb_ + 16 * k;
#pragma unroll
                    for (int bj = 0; bj < 2; ++bj) *(u32x4*)(base + (size_t)row * 2048 + ct + bj * HALF + cw) = pack8f(sigm4(opq4(acc[ai][bj][2 * mp + k][0])), sigm4(opq4(acc[ai][bj][2 * mp + k][1]))); }
                EPI_FENCE(); }
        }
    }
};
struct EpiMerge {
    static constexpr bool PERM = true, AFTER_DRAIN = false, MIDHOOK = true, FP8 = false;
    const bf16_t* GA; const bf16_t* GR; bf16_t* O;
    __device__ __forceinline__ void mid(f32x4 (&acc)[2][2][4][2], const Unit& u, int wr, int wc, int fr, int fq) const {
        EPI_ENTER(); const int cb = u.pn * BM + wc * 32 + 8 * fq;
        EPI_FOR_BATCH { EPI_BATCH(ai, mp); u32x4 ga[2][2], gr[2][2];
#pragma unroll
            for (int k = 0; k < 2; ++k)
#pragma unroll
                for (int bj = 0; bj < 2; ++bj) { const size_t ro = (size_t)(rb_ + 16 * k) * 2048 + cb + bj * HALF; ga[k][bj] = *(const u32x4*)(GA + ro); gr[k][bj] = *(const u32x4*)(GR + ro); }
#pragma unroll
            for (int k = 0; k < 2; ++k)
#pragma unroll
                for (int bj = 0; bj < 2; ++bj) { f32x4 a0, a1, r0, r1; unpack8(ga[k][bj], a0, a1); unpack8(gr[k][bj], r0, r1);
#pragma unroll
                    for (int j = 0; j < 4; ++j) { acc[ai][bj][2 * mp + k][0][j] *= a0[j] * __builtin_amdgcn_rcpf(fmaxf(r0[j], 1e-30f)); acc[ai][bj][2 * mp + k][1][j] *= a1[j] * __builtin_amdgcn_rcpf(fmaxf(r1[j], 1e-30f)); } }
            EPI_FENCE(); }
    }
    __device__ __forceinline__ void operator()(const f32x4 (&acc)[2][2][4][2], const Unit& u, int wr, int wc, int fr, int fq) const {
        EPI_ENTER(); const int cb = u.pn * BM + wc * 32 + 8 * fq;
        EPI_FOR_BATCH { EPI_BATCH(ai, mp); u32x4 gr[2][2];
#pragma unroll
            for (int k = 0; k < 2; ++k)
#pragma unroll
                for (int bj = 0; bj < 2; ++bj) gr[k][bj] = *(const u32x4*)(GR + (size_t)(rb_ + 16 * k) * 2048 + cb + bj * HALF);
#pragma unroll
            for (int k = 0; k < 2; ++k)
#pragma unroll
                for (int bj = 0; bj < 2; ++bj) { f32x4 r0, r1; unpack8(gr[k][bj], r0, r1);
                    *(u32x4*)(O + (size_t)(rb_ + 16 * k) * 2048 + cb + bj * HALF) = pack8f(acc[ai][bj][2 * mp + k][0] * r0, acc[ai][bj][2 * mp + k][1] * r1); }
            EPI_FENCE(); }
    }
};
template <bool RESBF> struct EpiResid {
    static constexpr bool PERM = true, AFTER_DRAIN = false, MIDHOOK = false, FP8 = false;
    const void* res; bf16_t* hb; float* ss;
    __device__ __forceinline__ void operator()(const f32x4 (&acc)[2][2][4][2], const Unit& u, int wr, int wc, int fr, int fq) const {
        EPI_ENTER(); const int cb = u.pn * BM + wc * 32 + 8 * fq;
        EPI_FOR_BATCH { EPI_BATCH(ai, mp); f32x4 r0[2][2], r1[2][2];
#pragma unroll
            for (int k = 0; k < 2; ++k)
#pragma unroll
                for (int bj = 0; bj < 2; ++bj) { const size_t ro = (size_t)(rb_ + 16 * k) * 2048 + cb + bj * HALF;
                    if (RESBF) unpack8(*(const u32x4*)((const bf16_t*)res + ro), r0[k][bj], r1[k][bj]);
                    else { r0[k][bj] = *(const f32x4*)((const float*)res + ro); r1[k][bj] = *(const f32x4*)((const float*)res + ro + 4); } }
#pragma unroll
            for (int k = 0; k < 2; ++k) { const int row = rb_ + 16 * k; float s = 0.f;
#pragma unroll
                for (int bj = 0; bj < 2; ++bj) { const f32x4 o0 = acc[ai][bj][2 * mp + k][0] + r0[k][bj], o1 = acc[ai][bj][2 * mp + k][1] + r1[k][bj];
                    *(u32x4*)(hb + (size_t)row * 2048 + cb + bj * HALF) = pack8f(o0, o1);
                    s += (o0[0] * o0[0] + o0[1] * o0[1]) + (o0[2] * o0[2] + o0[3] * o0[3]) + (o1[0] * o1[0] + o1[1] * o1[1]) + (o1[2] * o1[2] + o1[3] * o1[3]); }
                s += __shfl_xor(s, 16); s += __shfl_xor(s, 32);
                if (fq == 0) atomicAdd(ss + row, s); }
            EPI_FENCE(); }
    }
};
struct EpiUp {
    static constexpr bool PERM = true, AFTER_DRAIN = false, MIDHOOK = false, FP8 = false;
    const float* ss; bf16_t* Hd;
    __device__ __forceinline__ void operator()(const f32x4 (&acc)[2][2][4][2], const Unit& u, int wr, int wc, int fr, int fq) const {
        EPI_ENTER(); const int cb = u.pn * BM + wc * 32 + 8 * fq;
        float sv[2][4];
#pragma unroll
        for (int ai = 0; ai < 2; ++ai)
#pragma unroll
            for (int m = 0; m < 4; ++m) sv[ai][m] = ss[rowb + ai * HALF + m * 16];
        EPI_FOR_BATCH { EPI_BATCH(ai, mp);
#pragma unroll
            for (int k = 0; k < 2; ++k) { const int row = rb_ + 16 * k; const float rs = __builtin_amdgcn_rsqf(sv[ai][2 * mp + k] * (1.0f / 2048.0f) + NORM_EPS);
#pragma unroll
                for (int bj = 0; bj < 2; ++bj) { f32x4 a = acc[ai][bj][2 * mp + k][0] * rs, b2 = acc[ai][bj][2 * mp + k][1] * rs;
#pragma unroll
                    for (int j = 0; j < 4; ++j) { a[j] = fmaxf(a[j], 0.f); a[j] *= a[j]; b2[j] = fmaxf(b2[j], 0.f); b2[j] *= b2[j]; }
                    const u32x4 pk_ = pack8f(a, b2); *(u32x4*)(Hd + (size_t)row * DFF + cb + bj * HALF) = pk_;
                    } }
            EPI_FENCE(); }
    }
};

}
namespace att {
constexpr int D = 128, SQ = 4096, SKV = KVROWS, H = 1, HKV = 1, QOFF = 0, WINDOW = 1 << 20;
constexpr float THR = 8.f;
constexpr bool WSKIP = false;
constexpr float SCALE = 0.08838834764831845f;
constexpr int NW = 8, QBLK = 32, KVBLK = 64, QB = NW * QBLK;
constexpr int SHM_V = KVBLK * D * 2, SHM_K = KVBLK * D * 2;

using bf16 = __hip_bfloat16;
typedef short bf16x8 __attribute__((ext_vector_type(8)));
typedef short s16x4 __attribute__((ext_vector_type(4)));
typedef float f32x16 __attribute__((ext_vector_type(16)));
typedef float f32x4 __attribute__((ext_vector_type(4)));
typedef unsigned u32x4 __attribute__((ext_vector_type(4)));
template <class A, class Bt> struct same_t { static constexpr bool v = false; };
template <class A> struct same_t<A, A> { static constexpr bool v = true; };

#define KSWZ(row, colB) ((row) * 256 + ((colB) ^ (((row) & 7) << 4)))
#define SBAR() __builtin_amdgcn_sched_barrier(0)
__device__ __forceinline__ int v_st(int k, int c) { const int kk = (k & ~0xC) | ((k & 4) << 1) | ((k & 8) >> 1); return ((kk >> 3) * 4 + (c >> 5)) * 512 + ((kk & 7) * 32 + (c & 31)) * 2; }
__device__ __forceinline__ int v_rd_base(int lane) { return ((lane & 3) << 3) | (((lane >> 2) & 3) << 6) | (((lane >> 4) & 1) << 5) | (((lane >> 5) & 1) << 8); }
constexpr int v_rd_off(int d0, int ks, int half) { return d0 * 512 + ks * 4096 + half * 2048; }
__device__ __forceinline__ int crow(int r, int hi) { return (r & 3) + 8 * (r >> 2) + 4 * hi; }
__device__ __forceinline__ unsigned cvtpk(float lo, float hi) {
    typedef __bf16 cvb2_t __attribute__((ext_vector_type(2))); typedef float cvf2_t __attribute__((ext_vector_type(2))); const cvf2_t v_ = {lo, hi}; unsigned r = __builtin_bit_cast(unsigned, __builtin_convertvector(v_, cvb2_t)); asm volatile("" : "+v"(r)); return r;
}
__device__ __forceinline__ bf16x8 pack8(f32x4 a, f32x4 b) {
    u32x4 w = {cvtpk(a[0], a[1]), cvtpk(a[2], a[3]), cvtpk(b[0], b[1]), cvtpk(b[2], b[3])};
    return *reinterpret_cast<bf16x8*>(&w);
}
template <class T> __device__ __forceinline__ bf16x8 load8(const T* p) {
    if constexpr (same_t<T, float>::v) { return pack8(*(const f32x4*)p, *(const f32x4*)(p + 4)); }
    else { return *reinterpret_cast<const bf16x8*>(p); }
}
template <int VB, bool SK>
__device__ __forceinline__ void pv_tile(f32x16* o, int vb0, bf16x8 pa0, bf16x8 pa1, bf16x8 pa2, bf16x8 pa3, bool act) {
    if (SK && !act) return;
#define TRRD(dst, off) asm volatile("ds_read_b64_tr_b16 %0, %1 offset:%2" : "=&v"(dst) : "v"(vb0), "i"(off) : "memory")
#define PV_D0(d0) do { s16x4 l0, l1, l2, l3, h0, h1, h2, h3; constexpr int b_ = VB * SHM_V + v_rd_off(d0, 0, 0);     \
        TRRD(l0, b_); TRRD(h0, b_ + 2048); TRRD(l1, b_ + 4096); TRRD(h1, b_ + 6144); TRRD(l2, b_ + 8192); TRRD(h2, b_ + 10240); TRRD(l3, b_ + 12288); TRRD(h3, b_ + 14336); \
        asm volatile("s_waitcnt lgkmcnt(0)" ::: "memory"); SBAR();                 \
        o[d0] = __builtin_amdgcn_mfma_f32_32x32x16_bf16(pa0, (bf16x8){l0[0], l0[1], l0[2], l0[3], h0[0], h0[1], h0[2], h0[3]}, o[d0], 0, 0, 0);   \
        o[d0] = __builtin_amdgcn_mfma_f32_32x32x16_bf16(pa1, (bf16x8){l1[0], l1[1], l1[2], l1[3], h1[0], h1[1], h1[2], h1[3]}, o[d0], 0, 0, 0);   \
        o[d0] = __builtin_amdgcn_mfma_f32_32x32x16_bf16(pa2, (bf16x8){l2[0], l2[1], l2[2], l2[3], h2[0], h2[1], h2[2], h2[3]}, o[d0], 0, 0, 0);   \
        o[d0] = __builtin_amdgcn_mfma_f32_32x32x16_bf16(pa3, (bf16x8){l3[0], l3[1], l3[2], l3[3], h3[0], h3[1], h3[2], h3[3]}, o[d0], 0, 0, 0); } while (0)
    PV_D0(0); PV_D0(1); PV_D0(2); PV_D0(3);
#undef PV_D0
#undef TRRD
}

}
namespace att2 {
using att::bf16; using att::bf16x8; using att::f32x16; using att::u32x4; using att::s16x4;
constexpr int KB_OFF = 0, VB_OFF = 32768, HM_OFF = 98304, F_OFF = 100352, AL_OFF = 133120;
constexpr int LDS_END = AL_OFF + 8 * 256;
static_assert(LDS_END <= LDS_MISC, "attention scratch below the control words");
constexpr float C2 = 1.4426950408889634f * att::SCALE;
#define A2_KSWZ(row, colB) ((row) * 256 + ((colB) ^ (((row) & 7) << 4)))
typedef __attribute__((address_space(3))) unsigned char* lp_t;
__device__ __forceinline__ void pass(const bf16* Qb, const bf16* Kb, const bf16* V0, const bf16* V1, int P0, int NT, unsigned char* lds, f32x16 (&o)[4]) {
    int tid = threadIdx.x; asm volatile("" : "+v"(tid));
    const int wid = __builtin_amdgcn_readfirstlane(tid >> 6), lane = tid & 63, r32 = lane & 31, hi = lane >> 5, g = wid & 3, r = wid >> 2;
    const lp_t L = (lp_t)lds;
    lp_t krd[4];
#pragma unroll
    for (int q = 0; q < 4; ++q) krd[q] = L + KB_OFF + r * 8192 + A2_KSWZ(r32, (q * 16 + hi * 8) * 2);
    const int vrd = (int)(uintptr_t)lds + VB_OFF + r * 16384 + att::v_rd_base(lane);
    const lp_t hmw = L + HM_OFF + (wid * 32 + r32) * 4, hmr = L + HM_OFF + ((wid ^ 4) * 32 + r32) * 4;
    const lp_t fxw = L + F_OFF + (wid * 64 + lane) * 32, fxr = L + F_OFF + ((wid ^ 4) * 64 + lane) * 32;
    float* al = (float*)(lds + AL_OFF) + wid * 64;
    const bf16* kgs[2]; const bf16* vgs[2][2];
#pragma unroll
    for (int j = 0; j < 2; ++j) { const int pi = 2 * wid + j, row = 4 * pi + (lane >> 4), ch = (lane & 15) ^ (row & 7); kgs[j] = Kb + (size_t)row * 128 + ch * 8;
        const int s = 2 * pi + (lane >> 5), kk = 8 * (s >> 2) + ((lane & 31) >> 2), key = (kk & ~0xC) | ((kk & 4) << 1) | ((kk & 8) >> 1), col = 32 * (s & 3) + 8 * (lane & 3);
        vgs[0][j] = V0 + (size_t)key * 128 + col; vgs[1][j] = V1 + (size_t)key * 128 + col; }
    const lp_t dmw = L + wid * 2048;
#define A2_DMA(src_, dst_) __builtin_amdgcn_global_load_lds((const unsigned*)(src_), (__attribute__((address_space(3))) unsigned*)(dst_), 16, 0, 0)
#define A2_DMAK(t_, S_) do { A2_DMA(kgs[0] + (size_t)(t_) * 8192, dmw + KB_OFF + (S_) * 16384); A2_DMA(kgs[1] + (size_t)(t_) * 8192, dmw + KB_OFF + (S_) * 16384 + 1024); } while (0)
#define A2_DMAV(t_, S_) do { A2_DMA(vgs[0][0] + (size_t)(t_) * 8192, dmw + VB_OFF + (S_) * 32768); A2_DMA(vgs[0][1] + (size_t)(t_) * 8192, dmw + VB_OFF + (S_) * 32768 + 1024); \
        A2_DMA(vgs[1][0] + (size_t)(t_) * 8192, dmw + VB_OFF + (S_) * 32768 + 16384); A2_DMA(vgs[1][1] + (size_t)(t_) * 8192, dmw + VB_OFF + (S_) * 32768 + 16384 + 1024); } while (0)
    bf16x8 qr[8];
#pragma unroll
    for (int d0 = 0; d0 < 8; ++d0) qr[d0] = *(const bf16x8*)(Qb + (size_t)(32 * g + r32) * 128 + d0 * 16 + hi * 8);
    float m_reg = -1e30f, l_reg = 0.f, pmA = 0.f, pmB = 0.f; f32x16 pA, pB = f32x16{}; u32x4 fA0, fA1, fB0, fB1;
#pragma unroll
    for (int i = 0; i < 4; ++i) o[i] = f32x16{};
    fA0 = fA1 = fB0 = fB1 = (u32x4){0u, 0u, 0u, 0u};
    const int qpos = P0 + 32 * g + r32;
#define A2_QK(P_, S_) do { P_ = f32x16{}; \
        _Pragma("unroll") for (int d0 = 0; d0 < 8; ++d0) { const bf16x8 kf_ = *(__attribute__((address_space(3))) const bf16x8*)(krd[d0 & 3] + (S_) * 16384 + (d0 >> 2) * 128); P_ = __builtin_amdgcn_mfma_f32_32x32x16_bf16(kf_, qr[d0], P_, 0, 0, 0); } } while (0)
#define A2_MASK_HM(P_, PM_, t_, PAR_) do { const int kb_ = 64 * (t_) + 32 * r; \
        if (kb_ + 31 > P0 + 32 * g) { const int dq_ = qpos - kb_ - 4 * hi; _Pragma("unroll") for (int i = 0; i < 16; ++i) { const int c_ = (i & 3) + 8 * (i >> 2); if (dq_ - c_ < 0) P_[i] = -__builtin_inff(); } } \
        PM_ = fmaxf(fmaxf(P_[0], P_[1]), P_[2]); _Pragma("unroll") for (int i = 3; i < 15; i += 2) PM_ = fmaxf(fmaxf(PM_, P_[i]), P_[i + 1]); PM_ = fmaxf(PM_, P_[15]); \
        { auto rr_ = __builtin_amdgcn_permlane32_swap(__float_as_uint(PM_), __float_as_uint(PM_), false, false); PM_ = fmaxf(__uint_as_float(rr_[0]), __uint_as_float(rr_[1])); } \
        if (hi == 0) *(__attribute__((address_space(3))) float*)(hmw + (PAR_) * 1024) = PM_; } while (0)
#define A2_TRRD(dst, off) asm volatile("ds_read_b64_tr_b16 %0, %1 offset:%2" : "=&v"(dst) : "v"(vrd), "i"(off) : "memory")
#define A2_RD8(L0, H0, L1, H1, L2, H2, L3, H3, d0, S_) do { constexpr int b_ = (S_) * 32768 + (d0) * 512; \
        A2_TRRD(L0, b_); A2_TRRD(H0, b_ + 2048); A2_TRRD(L1, b_ + 4096); A2_TRRD(H1, b_ + 6144); A2_TRRD(L2, b_ + 8192); A2_TRRD(H2, b_ + 10240); A2_TRRD(L3, b_ + 12288); A2_TRRD(H3, b_ + 14336); } while (0)
#define A2_MM4(L0, H0, L1, H1, L2, H2, L3, H3, d0) do { \
        o[d0] = __builtin_amdgcn_mfma_f32_32x32x16_bf16(pa0_, (bf16x8){L0[0], L0[1], L0[2], L0[3], H0[0], H0[1], H0[2], H0[3]}, o[d0], 0, 0, 0); \
        o[d0] = __builtin_amdgcn_mfma_f32_32x32x16_bf16(pa1_, (bf16x8){L1[0], L1[1], L1[2], L1[3], H1[0], H1[1], H1[2], H1[3]}, o[d0], 0, 0, 0); \
        o[d0] = __builtin_amdgcn_mfma_f32_32x32x16_bf16(pa2_, (bf16x8){L2[0], L2[1], L2[2], L2[3], H2[0], H2[1], H2[2], H2[3]}, o[d0], 0, 0, 0); \
        o[d0] = __builtin_amdgcn_mfma_f32_32x32x16_bf16(pa3_, (bf16x8){L3[0], L3[1], L3[2], L3[3], H3[0], H3[1], H3[2], H3[3]}, o[d0], 0, 0, 0); } while (0)
#define A2_WAIT0() do { asm volatile("s_waitcnt lgkmcnt(0)" ::: "memory"); __builtin_amdgcn_sched_barrier(0); } while (0)
#define A2_PV_ALL(S_, V0_, V1_, V2_, V3_) do { s16x4 xa0, xa1, xa2, xa3, xa4, xa5, xa6, xa7; \
        A2_RD8(xa0, xa1, xa2, xa3, xa4, xa5, xa6, xa7, 0, S_); A2_WAIT0(); A2_MM4(xa0, xa1, xa2, xa3, xa4, xa5, xa6, xa7, 0); V0_; \
        A2_RD8(xa0, xa1, xa2, xa3, xa4, xa5, xa6, xa7, 1, S_); A2_WAIT0(); A2_MM4(xa0, xa1, xa2, xa3, xa4, xa5, xa6, xa7, 1); V1_; \
        A2_RD8(xa0, xa1, xa2, xa3, xa4, xa5, xa6, xa7, 2, S_); A2_WAIT0(); A2_MM4(xa0, xa1, xa2, xa3, xa4, xa5, xa6, xa7, 2); V2_; \
        A2_RD8(xa0, xa1, xa2, xa3, xa4, xa5, xa6, xa7, 3, S_); A2_WAIT0(); A2_MM4(xa0, xa1, xa2, xa3, xa4, xa5, xa6, xa7, 3); V3_; } while (0)
#define A2_PV_SETUP(FO0_, FO1_, PAR_) const u32x4 g0_ = *(__attribute__((address_space(3))) const u32x4*)(fxr + (PAR_) * 16384), g1_ = *(__attribute__((address_space(3))) const u32x4*)(fxr + (PAR_) * 16384 + 16); \
        const bf16x8 pa0_ = __builtin_bit_cast(bf16x8, r ? g0_ : FO0_), pa1_ = __builtin_bit_cast(bf16x8, r ? g1_ : FO1_), pa2_ = __builtin_bit_cast(bf16x8, r ? FO0_ : g0_), pa3_ = __builtin_bit_cast(bf16x8, r ? FO1_ : g1_)
#define A2_EXP(P_, lo_, hi_) do { _Pragma("unroll") for (int i = lo_; i < hi_; ++i) { P_[i] = __builtin_amdgcn_exp2f(fmaf(P_[i], C2, mnL_)); ps_ += P_[i]; } } while (0)
#define A2_PACK(P_, F_, B_) do { unsigned a0 = att::cvtpk(P_[B_ + 0], P_[B_ + 1]), a1 = att::cvtpk(P_[B_ + 2], P_[B_ + 3]), b0 = att::cvtpk(P_[B_ + 4], P_[B_ + 5]), b1 = att::cvtpk(P_[B_ + 6], P_[B_ + 7]); \
        auto r0 = __builtin_amdgcn_permlane32_swap(a0, b0, false, false); auto r1 = __builtin_amdgcn_permlane32_swap(a1, b1, false, false); F_ = (u32x4){r0[0], r1[0], r0[1], r1[1]}; } while (0)
#define A2_RESC(AL_) do { if (__any((AL_) < 1.f)) { if (hi == 0) al[r32] = (AL_); asm volatile("s_waitcnt lgkmcnt(0)" ::: "memory"); \
        _Pragma("unroll") for (int d_ = 0; d_ < 4; ++d_) _Pragma("unroll") for (int i = 0; i < 16; ++i) o[d_][i] *= al[att::crow(i, hi)]; } } while (0)
#define A2_PHASE(FIRST_, t, PAR_, PC_, PMC_, PN_, PMN_, FO0_, FO1_, FN0_, FN1_) do { \
        if ((t) + 2 < NT) A2_DMAK((t) + 2, PAR_);                         \
        A2_DMAV((t), PAR_);                                               \
        float alpha_ = 1.f; { const float pmax_ = fmaxf(PMC_, *(__attribute__((address_space(3))) const float*)(hmr + (PAR_) * 1024)); \
          if (!__builtin_expect(__all((pmax_ - m_reg) * att::SCALE <= att::THR), 1)) { const float mn_ = fmaxf(m_reg, pmax_); alpha_ = __builtin_amdgcn_exp2f((m_reg - mn_) * C2); m_reg = mn_; } } \
        const float mnL_ = -m_reg * C2; float ps_ = 0.f; \
          \
        if (r == 0) { if ((t) + 1 < NT) A2_QK(PN_, 1 - (PAR_)); } \
        if (FIRST_) { A2_EXP(PC_, 0, 16); A2_PACK(PC_, FN0_, 0); A2_PACK(PC_, FN1_, 8); } \
        else { A2_PV_SETUP(FO0_, FO1_, 1 - (PAR_)); \
            A2_PV_ALL(1 - (PAR_), A2_EXP(PC_, 0, 8), A2_EXP(PC_, 8, 16), A2_PACK(PC_, FN0_, 0), A2_PACK(PC_, FN1_, 8)); } \
        if (r != 0) { if ((t) + 1 < NT) A2_QK(PN_, 1 - (PAR_)); } \
        A2_RESC(alpha_);                                                  \
        { auto rr_ = __builtin_amdgcn_permlane32_swap(__float_as_uint(ps_), __float_as_uint(ps_), false, false); ps_ = __uint_as_float(rr_[0]) + __uint_as_float(rr_[1]); } \
        l_reg = l_reg * alpha_ + ps_; \
        *(__attribute__((address_space(3))) u32x4*)(fxw + (PAR_) * 16384) = FN0_; *(__attribute__((address_space(3))) u32x4*)(fxw + (PAR_) * 16384 + 16) = FN1_; \
        if ((t) + 1 < NT) { A2_MASK_HM(PN_, PMN_, (t) + 1, 1 - (PAR_)); } \
        __syncthreads(); } while (0)
    A2_DMAK(0, 0);
    if (NT > 1) A2_DMAK(1, 1);
    __syncthreads();
    A2_QK(pA, 0); A2_MASK_HM(pA, pmA, 0, 0);
    __syncthreads();
    A2_PHASE(true, 0, 0, pA, pmA, pB, pmB, fB0, fB1, fA0, fA1);
    for (int t = 1; t < NT; t += 2) {
        A2_PHASE(false, t, 1, pB, pmB, pA, pmA, fA0, fA1, fB0, fB1);
        A2_PHASE(false, t + 1, 0, pA, pmA, pB, pmB, fB0, fB1, fA0, fA1);
    }
    { A2_PV_SETUP(fA0, fA1, 0); A2_PV_ALL(0, (void)0, (void)0, (void)0, (void)0); }
    float* hm = (float*)(lds + HM_OFF);
    if (hi == 0) hm[wid * 32 + r32] = l_reg;
    __syncthreads();
    { const float lt = l_reg + hm[(wid ^ 4) * 32 + r32]; if (hi == 0) al[32 + r32] = lt; }
    asm volatile("s_waitcnt lgkmcnt(0)" ::: "memory");
#pragma unroll
    for (int i = 0; i < 16; ++i) { const float rl = __builtin_amdgcn_rcpf(al[32 + att::crow(i, hi)]);
#pragma unroll
        for (int d0 = 0; d0 < 4; ++d0) o[d0][i] *= rl; }
    __syncthreads();
#undef A2_DMA
#undef A2_DMAK
#undef A2_DMAV
#undef A2_QK
#undef A2_MASK_HM
#undef A2_TRRD
#undef A2_RD8
#undef A2_MM4
#undef A2_WAIT0
#undef A2_PV_ALL
#undef A2_PV_SETUP
#undef A2_EXP
#undef A2_PACK
#undef A2_RESC
#undef A2_PHASE
}

__device__ __forceinline__ void unit(const bf16* Q0, const bf16* Q1, const bf16* K0, const bf16* K1, const bf16* V0, const bf16* V1, unsigned short* Xrow, float lam, int P0, int NT, unsigned char* lds) {
    f32x16 o[4]; unsigned o1p[4][8];
    pass(Q0, K0, V0, V1, P0, NT, lds, o);
#pragma unroll
    for (int d0 = 0; d0 < 4; ++d0)
#pragma unroll
        for (int i = 0; i < 8; ++i) o1p[d0][i] = att::cvtpk(o[d0][2 * i], o[d0][2 * i + 1]);
    pass(Q1, K1, V0, V1, P0, NT, lds, o);
    int tid = threadIdx.x; asm volatile("" : "+v"(tid));
    const int wid = __builtin_amdgcn_readfirstlane(tid >> 6), lane = tid & 63, r32 = lane & 31, hi = lane >> 5, g = wid & 3, r = wid >> 2;
    float* xs = (float*)(lds + HM_OFF);
    float sq[16];
#pragma unroll
    for (int i = 0; i < 16; ++i) { float s = 0.f;
#pragma unroll
        for (int d0 = 0; d0 < 4; ++d0) { const unsigned w = o1p[d0][i >> 1]; const float o1 = __uint_as_float((i & 1) ? (w & 0xffff0000u) : (w << 16)); const float d = o1 - lam * o[d0][i]; o[d0][i] = d; s += d * d; }
        s += __shfl_xor(s, 1); s += __shfl_xor(s, 2); s += __shfl_xor(s, 4); s += __shfl_xor(s, 8); s += __shfl_xor(s, 16); sq[i] = s;
        if (r32 == 0) xs[wid * 32 + att::crow(i, hi)] = s; }
    __syncthreads();
    unsigned short* Ow = Xrow + (size_t)(32 * g) * 2048 + 128 * r;
#pragma unroll
    for (int i = 0; i < 16; ++i) { const int orow = att::crow(i, hi); const float rs = __builtin_amdgcn_rsqf((sq[i] + xs[(wid ^ 4) * 32 + orow]) * (1.0f / 256.0f) + NORM_EPS);
#pragma unroll
        for (int d0 = 0; d0 < 4; ++d0) { const float v = o[d0][i] * rs; const float vn = __shfl_xor(v, 1);
            if ((r32 & 1) == 0) *(unsigned*)(Ow + (size_t)orow * 2048 + d0 * 32 + r32) = att::cvtpk(v, vn); } }
    __syncthreads();
}
}
#define LAS __attribute__((address_space(3)))
typedef short bf16x8 __attribute__((ext_vector_type(8)));
typedef short v4i16_t __attribute__((ext_vector_type(4)));
typedef float f32x4 __attribute__((ext_vector_type(4)));
typedef float f32x16 __attribute__((ext_vector_type(16)));
typedef unsigned u32x4 __attribute__((ext_vector_type(4)));
typedef unsigned u32x2 __attribute__((ext_vector_type(2)));
#define LDS_WAIT() asm volatile("s_waitcnt lgkmcnt(0)" ::: "memory")
#define XB_TMO      128
#define XB_XCNT(j)  (256  + 64 * (j))
#define XB_XSUB(j)  (1280 + 64 * (j))
#define XB_XGEN(j)  (2304 + 64 * (j))
#define XB_TOP      3328
#define XB_TOPGEN   3392
#define XCD_BAR_WORDS 3456
#define XB_SPIN_CAP (1u << 18)

__device__ __forceinline__ unsigned xb_ld(unsigned* p)              { return __hip_atomic_load(p, __ATOMIC_RELAXED, __HIP_MEMORY_SCOPE_AGENT); }
__device__ __forceinline__ unsigned xb_add(unsigned* p, unsigned v) { return __hip_atomic_fetch_add(p, v, __ATOMIC_RELAXED, __HIP_MEMORY_SCOPE_AGENT); }
__device__ __forceinline__ unsigned xb_xcc_id() { return (unsigned)__builtin_amdgcn_s_getreg((3 << 11) | 20) & 0xFu; }
#define XB_SPIN(cond, bar) do { unsigned _sp = 0; while (cond) { __builtin_amdgcn_s_sleep(1); \
    if ((++_sp & 255u) == 0u) { if (xb_ld(&(bar)[XB_TMO])) break; if (_sp > XB_SPIN_CAP) { atomicAdd(&(bar)[XB_TMO], 1u); break; } } } } while (0)

struct XcdBarrier {
    unsigned* bar; unsigned x;
    volatile LAS unsigned* st;
};

__device__ __forceinline__ XcdBarrier xcd_barrier_post(unsigned* bar, volatile LAS unsigned* st) {
    XcdBarrier b; b.bar = bar; b.x = xb_xcc_id(); b.st = st;
    if (threadIdx.x == 0) (void)xb_add(&bar[XB_XCNT(b.x)], 1u);
    return b;
}
__device__ __forceinline__ void xcd_barrier_complete(unsigned* bar, unsigned x, unsigned& nloc, unsigned& nx) {
    const unsigned G = gridDim.x * gridDim.y * gridDim.z;
    unsigned sum, cnt, mine, sp = 0u;
    for (;;) {
        sum = 0u; cnt = 0u; mine = 0u;
#pragma unroll
        for (unsigned j = 0; j < 16; ++j) { const unsigned c = xb_ld(&bar[XB_XCNT(j)]); sum += c; cnt += (c > 0u) ? 1u : 0u; mine = (j == x) ? c : mine; }
        if (sum == G) break;
        __builtin_amdgcn_s_sleep(1);
        if ((++sp & 255u) == 0u) { if (xb_ld(&bar[XB_TMO])) break; if (sp > XB_SPIN_CAP) { atomicAdd(&bar[XB_TMO], 1u); break; } }
    }
    nloc = mine > 0u ? mine : 1u; nx = cnt > 0u ? cnt : 1u;
}

__device__ __forceinline__ void xcd_barrier(const XcdBarrier& b) {
    asm volatile("s_waitcnt vmcnt(0)" ::: "memory");
    __syncthreads();
    if (threadIdx.x == 0) {
        unsigned* bar = b.bar;
        __builtin_amdgcn_s_waitcnt(0);
        unsigned nloc = b.st[0], nx = b.st[1];
        if (nloc == 0u) { xcd_barrier_complete(bar, b.x, nloc, nx); b.st[0] = nloc; b.st[1] = nx; }
        const unsigned old = xb_add(&bar[XB_XSUB(b.x)], 1u);
        const unsigned gen = old / nloc;
        if (old + 1u == (gen + 1u) * nloc) {
            __builtin_amdgcn_fence(__ATOMIC_RELEASE, "agent");
            asm volatile("s_waitcnt vmcnt(0)" ::: "memory");
            const unsigned og = xb_add(&bar[XB_TOP], 1u);
            const unsigned tg = og / nx;
            if (og + 1u == (tg + 1u) * nx) xb_add(&bar[XB_TOPGEN], 1u);
            else XB_SPIN(xb_ld(&bar[XB_TOPGEN]) == tg, bar);
            __builtin_amdgcn_fence(__ATOMIC_ACQUIRE, "agent");
            xb_add(&bar[XB_XGEN(b.x)], 1u);
            asm volatile("s_waitcnt vmcnt(0)" ::: "memory");
        } else {
            XB_SPIN(xb_ld(&bar[XB_XGEN(b.x)]) == gen, bar);
            __builtin_amdgcn_fence(__ATOMIC_ACQUIRE, "agent");
            asm volatile("s_waitcnt vmcnt(0)" ::: "memory");
        }
    }
    __syncthreads();
}

struct Params {
    const float *x, *meta, *g1, *w_in, *lq1, *lk1, *lq2, *lk2, *subg, *w_pa, *w_pr, *w_o, *g2, *w_up, *w_dn, *gf;
    float* out; unsigned char* ws;
};

__device__ __forceinline__ unsigned cvtpk(float lo, float hi) { typedef __bf16 cvb2_t __attribute__((ext_vector_type(2))); typedef float cvf2_t __attribute__((ext_vector_type(2))); const cvf2_t v_ = {lo, hi}; return __builtin_bit_cast(unsigned, __builtin_convertvector(v_, cvb2_t)); }
__device__ __forceinline__ float bf2f(unsigned short v) { return __uint_as_float((unsigned)v << 16); }
__device__ __forceinline__ unsigned short f2bf(float f) { return (unsigned short)(cvtpk(f, f) & 0xffffu); }
__device__ __forceinline__ float wave_sum(float v) {
#pragma unroll
    for (int o = 1; o < 64; o <<= 1) v += __shfl_xor(v, o);
    return v;
}
__device__ __forceinline__ float head_lg2(int h) { return h == 0 ? -0.04580368961312479f : h == 1 ? -0.02272007650008353f : h == 2 ? -0.011315313227834146f : -0.005646563141142063f; }

__device__ __forceinline__ int win_dest(int n) {
    if (n < 2048) { const int d = n & 127; return (n & ~127) + 8 * ((d & 63) >> 2) + 4 * (d >> 6) + (d & 3); }
    if (n >= 3072 && n < 5120) { const int o = n - 3072, d = o & 255; return 3072 + (o & ~255) + 8 * ((d & 127) >> 2) + 4 * (d >> 7) + (d & 3); }
    return n;
}
__device__ __forceinline__ unsigned pk4_fp8(float a, float b, float c_, float d) { int w = __builtin_amdgcn_cvt_pk_fp8_f32(a, b, 0, false); w = __builtin_amdgcn_cvt_pk_fp8_f32(c_, d, w, true); return (unsigned)w; }
template <int MODE>
__device__ __forceinline__ void transpose_item(const float* W, int K, int N, bf16_t* WT, const float* g, LAS float* scr, int item, int lane, int ldk = 0, int nbu = 0) {
    if (ldk == 0) ldk = K;
    const int nblk = nbu ? nbu : N / 32, kb = item / nblk, nb = item - kb * nblk, k0 = 64 * kb, n0 = 32 * nb;
#pragma unroll 8
    for (int i = 0; i < 32; ++i) { const int kk = 2 * i + (lane >> 5); float v = W[(size_t)(k0 + kk) * N + n0 + (lane & 31)];
        if (MODE == 0 || MODE == 3) v *= g[k0 + kk];
        if (MODE == 1) v *= g[(k0 + kk) & 255] * 0.8f;
        scr[kk * 33 + (lane & 31)] = v; }
    LDS_WAIT(); asm volatile("" ::: "memory");
    const int c = lane & 7;
#pragma unroll
    for (int j = 0; j < 4; ++j) { const int n = (lane >> 3) + 8 * j; const LAS float* s = scr + (8 * c) * 33 + n;
        u32x4 o; o.x = cvtpk(s[0 * 33], s[1 * 33]); o.y = cvtpk(s[2 * 33], s[3 * 33]); o.z = cvtpk(s[4 * 33], s[5 * 33]); o.w = cvtpk(s[6 * 33], s[7 * 33]);
        const int dest = (MODE == 0) ? win_dest(n0 + n) : (n0 + n);
        *(u32x4*)(WT + (size_t)dest * ldk + k0 + 8 * c) = o; }
    LDS_WAIT(); asm volatile("" ::: "memory");
}
__device__ __forceinline__ void gate8_item(const float* W, unsigned char* W8, const float* g, LAS float* scr, int item, int lane) {
    const int kp = item / (NF8 / 32), nb = item - kp * (NF8 / 32), n0 = NBF + 32 * nb, c = lane & 7;
#pragma unroll 1
    for (int h = 0; h < 2; ++h) { const int k0 = 128 * kp + 64 * h;
#pragma unroll 8
        for (int i = 0; i < 32; ++i) { const int kk = 2 * i + (lane >> 5); scr[kk * 33 + (lane & 31)] = W[(size_t)(k0 + kk) * INW + n0 + (lane & 31)] * g[k0 + kk]; }
        LDS_WAIT(); asm volatile("" ::: "memory");
#pragma unroll
        for (int j = 0; j < 4; ++j) { const int n = (lane >> 3) + 8 * j; const LAS float* s = scr + (8 * c) * 33 + n;
            u32x2 o; o.x = pk4_fp8(s[0 * 33] * 32.f, s[1 * 33] * 32.f, s[2 * 33] * 32.f, s[3 * 33] * 32.f); o.y = pk4_fp8(s[4 * 33] * 32.f, s[5 * 33] * 32.f, s[6 * 33] * 32.f, s[7 * 33] * 32.f);
            *(u32x2*)(W8 + (size_t)(n0 + n - NBF) * DM + k0 + 8 * c) = o; }
        LDS_WAIT(); asm volatile("" ::: "memory"); }
}
__device__ __forceinline__ void rms_row_to_bf16(const float* xrow, bf16_t* orow, int lane, unsigned char* orow8 = nullptr) {
    const f32x4* xr = (const f32x4*)xrow + lane; f32x4 v[8]; float s = 0.f;
#pragma unroll
    for (int j = 0; j < 8; ++j) { v[j] = xr[64 * j]; s += (v[j].x * v[j].x + v[j].y * v[j].y) + (v[j].z * v[j].z + v[j].w * v[j].w); }
    const float rs = 1.0f / sqrtf(wave_sum(s) * (1.0f / 2048.0f) + NORM_EPS);
    u32x2* o8 = (u32x2*)orow + lane;
#pragma unroll
    for (int j = 0; j < 8; ++j) { u32x2 w; w.x = cvtpk(v[j].x * rs, v[j].y * rs); w.y = cvtpk(v[j].z * rs, v[j].w * rs); o8[64 * j] = w; }
    if (orow8) {
        unsigned* o4 = (unsigned*)orow8 + lane;
#pragma unroll
        for (int j = 0; j < 8; ++j) o4[64 * j] = pk4_fp8(v[j].x * rs, v[j].y * rs, v[j].z * rs, v[j].w * rs); }
}
__device__ __forceinline__ void rope_entry(int pos, int i, double rbase, float& c, float& s) {
    double acc = 1.0, bb = rbase;
#pragma unroll
    for (int k = 0; k < 7; ++k) { if (i & (1 << k)) acc *= bb; bb *= bb; }
    const float inv = (float)acc, ang = (float)pos * inv;
    const double x = (double)ang, kq = __builtin_rint(x * 0.63661977236758134308); const int q = (int)kq;
    double r = __builtin_fma(-kq, 1.57079632679489655800e+00, x); r = __builtin_fma(-kq, 6.12323399573676603587e-17, r);
    const double r2 = r * r;
    double sp = r2 * (-2.50521083854417187751e-08) + 2.75573192239858906526e-06; sp = sp * r2 - 1.98412698412698412698e-04; sp = sp * r2 + 8.33333333333333333333e-03; sp = sp * r2 - 1.66666666666666666667e-01;
    const double sn = r + r * r2 * sp;
    double cp = r2 * 2.08767569878680989792e-09 - 2.75573192239858906526e-07; cp = cp * r2 + 2.48015873015873015873e-05; cp = cp * r2 - 1.38888888888888888889e-03; cp = cp * r2 + 4.16666666666666666667e-02; cp = cp * r2 - 0.5;
    const double cs = 1.0 + r2 * cp;
    const int qq = q & 3;
    const double so = (qq == 0) ? sn : (qq == 1) ? cs : (qq == 2) ? -sn : -cs, co = (qq == 0) ? cs : (qq == 1) ? -sn : (qq == 2) ? -cs : sn;
    c = (float)co; s = (float)so;
}
__device__ __forceinline__ void zero_range(unsigned char* p, size_t bytes, int gtid, int gn) {
    u32x4* q = (u32x4*)p; const size_t n = bytes / 16;
    for (size_t i = gtid; i < n; i += gn) q[i] = (u32x4){0u, 0u, 0u, 0u};
}
__device__ __forceinline__ void p0_prologue(const Params& P, LAS unsigned char* lds3) {
    unsigned char* ws = P.ws;
    const int tid = threadIdx.x, lane = tid & 63, wave = __builtin_amdgcn_readfirstlane(tid >> 6);
    const int G = gridDim.x, gw = blockIdx.x * 8 + wave, NGW = G * 8, gtid = blockIdx.x * 512 + tid, gn = G * 512;
    LAS float* scr = (LAS float*)(lds3 + wave * 16384);
    constexpr int I_G8 = (DM / 128) * (NF8 / 32), I_IN = (DM / 64) * (NBF / 32), I_PA = (1024 / 64) * (DM / 32), I_PR = I_PA, I_O = (DM / 64) * (DM / 32);
    constexpr int NITEMS = I_G8 + I_IN + I_PA + I_PR + I_O;
    for (int it = gw; it < NITEMS; it += NGW) {
        int r = it;
        if (r < I_G8) { gate8_item(P.w_in, ws + WS_W8, P.g1, scr, r, lane); continue; } r -= I_G8;
        if (r < I_IN) { transpose_item<0>(P.w_in, DM, INW, (bf16_t*)(ws + WS_WIN), P.g1, scr, r, lane, 0, NBF / 32); continue; } r -= I_IN;
        if (r < I_PA) { transpose_item<1>(P.w_pa, 1024, DM, (bf16_t*)(ws + WS_WCAT), P.subg, scr, r, lane, 2048); continue; } r -= I_PA;
        if (r < I_PR) { transpose_item<2>(P.w_pr, 1024, DM, (bf16_t*)(ws + WS_WCAT) + 1024, nullptr, scr, r, lane, 2048); continue; } r -= I_PR;
        transpose_item<2>(P.w_o, DM, DM, (bf16_t*)(ws + WS_WO), nullptr, scr, r, lane);
    }
    for (int m = gw; m < MTOK + NMETA; m += NGW) {
        if (m < MTOK) rms_row_to_bf16(P.x + (size_t)m * DM, (bf16_t*)(ws + WS_XN) + (size_t)m * DM, lane, ws + WS_XN8 + (size_t)m * DM);
        else rms_row_to_bf16(P.meta + (size_t)(m - MTOK) * DM, (bf16_t*)(ws + WS_XNM) + (size_t)(m - MTOK) * DM, lane);
    }
    {
        float* daC = (float*)(ws + WS_DAC); float* daS = (float*)(ws + WS_DAS); float* rtC = (float*)(ws + WS_RTC); float* rtS = (float*)(ws + WS_RTS);
        for (int e = gtid; e < 4112 * 64; e += gn) { float c, s; rope_entry(e >> 6, e & 63, 0.8659643233600653, c, s); daC[e] = c; daS[e] = s; }
        for (int e = gtid; e < 4112 * 128; e += gn) { float c, s; rope_entry(e >> 7, e & 127, 0.9305720409296990, c, s); rtC[e] = c; rtS[e] = s; }
    }
    zero_range(ws + WS_SS1, 131072, gtid, gn);
    for (int u = 0; u < 32; ++u) {
        zero_range(ws + WS_K + ((size_t)u * KVROWS + 4112) * 256, 48 * 256, gtid, gn);
        zero_range(ws + WS_V + ((size_t)u * KVROWS + 4112) * 256, 48 * 256, gtid, gn);
    }
    for (int u = 0; u < 16; ++u) {
        zero_range(ws + WS_RK + (size_t)u * RKROWS * 512, 112 * 512, gtid, gn);
        zero_range(ws + WS_RV + (size_t)u * RKROWS * 512, 112 * 512, gtid, gn);
    }
}

__device__ __forceinline__ void convert_mlp_weights(const Params& P, LAS unsigned char* lds3) {
    int tid = threadIdx.x; asm volatile("" : "+v"(tid));
    const int lane = tid & 63, wave = __builtin_amdgcn_readfirstlane(tid >> 6), gw = blockIdx.x * 8 + wave, NGW = gridDim.x * 8;
    LAS float* scr = (LAS float*)(lds3 + wave * 16384);
    constexpr int I_UP = (DM / 64) * (DFF / 32), I_DN = (DFF / 64) * (DM / 32);
    for (int it = gw; it < I_UP + I_DN; it += NGW) {
        if (it < I_UP) transpose_item<3>(P.w_up, DM, DFF, (bf16_t*)(P.ws + WS_WUP), P.g2, scr, it, lane);
        else transpose_item<2>(P.w_dn, DFF, DM, (bf16_t*)(P.ws + WS_WDN), nullptr, scr, it - I_UP, lane);
    }
    __syncthreads();
}
__device__ __forceinline__ void meta_tile(int ti, unsigned char* ws, LAS unsigned char* lds3, int lane, int wave) {
    typedef float f32x4v __attribute__((ext_vector_type(4)));
    const int sect = ti >> 6, tj = ti & 63;
    const int nbase = (sect == 0 ? 1024 : sect == 1 ? 2048 : sect == 2 ? 4096 : 5120) + 16 * tj;
    const int c16 = lane & 15, kg = lane >> 4;
    const bf16_t* ap = (const bf16_t*)(ws + WS_XNM) + c16 * 2048 + kg * 8 + 256 * wave;
    const bf16_t* bp = (const bf16_t*)(ws + WS_WIN) + (size_t)(nbase + c16) * 2048 + kg * 8 + 256 * wave;
    f32x4v acc = {0.f, 0.f, 0.f, 0.f};
#pragma unroll
    for (int ks = 0; ks < 8; ++ks) { const bf16x8 a = *(const bf16x8*)(ap + 32 * ks), b = *(const bf16x8*)(bp + 32 * ks); acc = __builtin_amdgcn_mfma_f32_16x16x32_bf16(a, b, acc, 0, 0, 0); }
    LAS f32x4v* red = (LAS f32x4v*)lds3;
    red[wave * 64 + lane] = acc;
    __syncthreads();
    if (wave != 0) return;
#pragma unroll
    for (int w = 1; w < 8; ++w) acc += red[w * 64 + lane];
    const float* daC = (const float*)(ws + WS_DAC); const float* daS = (const float*)(ws + WS_DAS); const float* rtC = (const float*)(ws + WS_RTC); const float* rtS = (const float*)(ws + WS_RTS);
    const int h = tj >> 4;
#pragma unroll
    for (int r = 0; r < 4; ++r) {
        const int pos = 4 * kg + r; const float x = acc[r], xp = __shfl_xor(x, 4);
        if (sect == 0) { const int p = 16 * (tj & 7) + c16, c = (tj >> 3) & 1, d = 4 * (p >> 3) + (p & 3); const float cv = daC[pos * 64 + d], sv = daS[pos * 64 + d];
            const unsigned short o = f2bf(((p >> 2) & 1) ? x * cv + xp * sv : x * cv - xp * sv);
            for (int b = 0; b < NB; ++b) ((bf16_t*)(ws + WS_K))[((size_t)((b * 4 + h) * 2 + c) * KVROWS + pos) * 128 + p] = o;
        } else if (sect == 1) { const int col = 16 * (tj & 7) + c16, vh = (tj >> 3) & 1; const unsigned short o = f2bf(x);
            for (int b = 0; b < NB; ++b) ((bf16_t*)(ws + WS_V))[((size_t)((b * 4 + h) * 2 + vh) * KVROWS + pos) * 128 + col] = o;
        } else if (sect == 2) { const int p = 16 * (tj & 15) + c16, d = 4 * (p >> 3) + (p & 3); const float cv = rtC[pos * 128 + d], sv = rtS[pos * 128 + d];
            const unsigned short o = f2bf((((p >> 2) & 1) ? x * cv + xp * sv : x * cv - xp * sv) * 0.0625f);
            for (int b = 0; b < NB; ++b) ((bf16_t*)(ws + WS_RK))[((size_t)(b * 4 + h) * RKROWS + 112 + pos) * 256 + p] = o;
        } else { const int col = 16 * (tj & 15) + c16; const unsigned short o = f2bf(x);
            for (int b = 0; b < NB; ++b) ((bf16_t*)(ws + WS_RV))[((size_t)(b * 4 + h) * RKROWS + 112 + pos) * 256 + col] = o;
        }
    }
}

__device__ __forceinline__ bf16x8 trfrag(LAS const char* p) {
    const v4i16_t l = __builtin_amdgcn_ds_read_tr16_b64_v4i16((LAS v4i16_t*)p), h = __builtin_amdgcn_ds_read_tr16_b64_v4i16((LAS v4i16_t*)(p + 2048));
    return (bf16x8){l[0], l[1], l[2], l[3], h[0], h[1], h[2], h[3]};
}
__device__ __forceinline__ bf16x8 scale8(bf16x8 v, float f) {
    u32x4 w = __builtin_bit_cast(u32x4, v); f32x4 a, b; pg8::unpack8(w, a, b); a *= f; b *= f; return __builtin_bit_cast(bf16x8, pg8::pack8f(a, b));
}
__device__ __forceinline__ void ret_state_item(int item, unsigned char* ws, LAS unsigned char* lds3) {
    int tid = threadIdx.x; asm volatile("" : "+v"(tid));
    const int wid = __builtin_amdgcn_readfirstlane(tid >> 6), lane = tid & 63, r32 = lane & 31, hi = lane >> 5;
    const int bh = item >> 1, dh = item & 1, h = bh & 3;
    const float lg2 = head_lg2(h), gC = __builtin_amdgcn_exp2f(128.f * lg2);
    const bf16_t* Kp = (const bf16_t*)(ws + WS_RK) + (size_t)bh * RKROWS * 256 + dh * 128;
    const bf16_t* Vp = (const bf16_t*)(ws + WS_RV) + (size_t)bh * RKROWS * 256;
    bf16_t* RTp = (bf16_t*)(ws + WS_RT) + (size_t)bh * 32 * 65536;
    const int sr = tid >> 4, sc = (tid & 15) * 8, st0 = att::v_st(sr, sc), st1 = att::v_st(32 + sr, sc);
    const float z0 = __builtin_amdgcn_exp2f((float)(127 - sr) * lg2), z32 = __builtin_amdgcn_exp2f((float)(95 - sr) * lg2), z64 = __builtin_amdgcn_exp2f((float)(63 - sr) * lg2), z96 = __builtin_amdgcn_exp2f((float)(31 - sr) * lg2);
    bf16x8 sv[8], sk[4];
#define RS_LOAD(c) do { const size_t r0_ = (size_t)(128 * (c) + sr) * 256; \
        _Pragma("unroll") for (int kh = 0; kh < 2; ++kh) { _Pragma("unroll") for (int ch = 0; ch < 2; ++ch) { \
            sv[(kh * 2 + ch) * 2] = *(const bf16x8*)(Vp + r0_ + (size_t)kh * 64 * 256 + ch * 128 + sc); sv[(kh * 2 + ch) * 2 + 1] = *(const bf16x8*)(Vp + r0_ + (size_t)(kh * 64 + 32) * 256 + ch * 128 + sc); } \
            sk[kh * 2] = *(const bf16x8*)(Kp + r0_ + (size_t)kh * 64 * 256 + sc); sk[kh * 2 + 1] = *(const bf16x8*)(Kp + r0_ + (size_t)(kh * 64 + 32) * 256 + sc); } } while (0)
    f32x16 acc[4];
#pragma unroll
    for (int i = 0; i < 4; ++i) acc[i] = f32x16{};
    RS_LOAD(0);
    const int rdb = att::v_rd_base(lane);
    for (int c = 0; c < 32; ++c) {
#pragma unroll
        for (int t4 = 0; t4 < 4; ++t4) { *(LAS bf16x8*)(lds3 + t4 * 16384 + st0) = sv[t4 * 2]; *(LAS bf16x8*)(lds3 + t4 * 16384 + st1) = sv[t4 * 2 + 1]; }
        *(LAS bf16x8*)(lds3 + 4 * 16384 + st0) = scale8(sk[0], z0); *(LAS bf16x8*)(lds3 + 4 * 16384 + st1) = scale8(sk[1], z32);
        *(LAS bf16x8*)(lds3 + 5 * 16384 + st0) = scale8(sk[2], z64); *(LAS bf16x8*)(lds3 + 5 * 16384 + st1) = scale8(sk[3], z96);
        __syncthreads();
        if (c + 1 < 32) RS_LOAD(c + 1);
#pragma unroll
        for (int i = 0; i < 4; ++i) acc[i] *= gC;
        bf16x8 af[8];
#pragma unroll
        for (int ks = 0; ks < 8; ++ks) af[ks] = trfrag((LAS const char*)lds3 + ((ks >> 2) * 2 + (wid >> 2)) * 16384 + rdb + (wid & 3) * 512 + (ks & 3) * 4096);
#pragma unroll
        for (int dt = 0; dt < 4; ++dt)
#pragma unroll
            for (int ks = 0; ks < 8; ++ks) { const bf16x8 bfr = trfrag((LAS const char*)lds3 + (4 + (ks >> 2)) * 16384 + rdb + dt * 512 + (ks & 3) * 4096);
                acc[dt] = __builtin_amdgcn_mfma_f32_32x32x16_bf16(af[ks], bfr, acc[dt], 0, 0, 0); }
        bf16_t* dst = RTp + (size_t)c * 65536 + dh * 128 + r32;
#pragma unroll
        for (int dt = 0; dt < 4; ++dt)
#pragma unroll
            for (int r = 0; r < 16; ++r) dst[(size_t)(32 * wid + att::crow(r, hi)) * 256 + 32 * dt] = f2bf(acc[dt][r]);
        __syncthreads();
    }
#undef RS_LOAD
}
__device__ __forceinline__ void ret_out_item(int item, unsigned char* ws, unsigned char* lds, LAS unsigned char* lds3) {
    int tid = threadIdx.x; asm volatile("" : "+v"(tid));
    const int wid = __builtin_amdgcn_readfirstlane(tid >> 6), lane = tid & 63, r32 = lane & 31, hi = lane >> 5;
    const int bh = item >> 5, cc = item & 31, h = bh & 3, b = bh >> 2, ib = wid >> 1, eh = wid & 1;
    const float lg2 = head_lg2(h);
    const bf16_t* Qc = (const bf16_t*)(ws + WS_RQ) + ((size_t)bh * 4096 + 128 * cc) * 256;
    const bf16_t* Kc = (const bf16_t*)(ws + WS_RK) + ((size_t)bh * RKROWS + 128 + 128 * cc) * 256;
    const bf16_t* Vc = (const bf16_t*)(ws + WS_RV) + ((size_t)bh * RKROWS + 128 + 128 * cc) * 256;
    const bf16_t* RTc = (const bf16_t*)(ws + WS_RT) + ((size_t)bh * 32 + cc) * 65536;
#define RO_DMA(src_, off_) __builtin_amdgcn_global_load_lds((const unsigned*)(src_), (LAS unsigned*)(lds3 + (off_)), 16, 0, 0)
#pragma unroll
    for (int hf = 0; hf < 2; ++hf)
#pragma unroll
        for (int j = 0; j < 8; ++j) { const int pi = 8 * wid + j, e = 4 * pi + (lane >> 4), c16 = (lane & 8) | ((lane & 7) ^ (e & 7));
            RO_DMA(RTc + (size_t)e * 256 + hf * 128 + c16 * 8, hf * 65536 + pi * 1024); }
    bf16x8 qr[16];
#pragma unroll
    for (int ks = 0; ks < 16; ++ks) qr[ks] = *(const bf16x8*)(Qc + (size_t)(32 * ib + r32) * 256 + 16 * ks + 8 * hi);
    f32x16 o[4];
#pragma unroll
    for (int i = 0; i < 4; ++i) o[i] = f32x16{};
    int cq[4];
#pragma unroll
    for (int q = 0; q < 4; ++q) cq[q] = ((2 * q + hi) ^ (r32 & 7)) << 4;
    __syncthreads();
#pragma unroll
    for (int ks = 0; ks < 16; ++ks) { LAS const unsigned char* rb = lds3 + (ks >> 3) * 65536 + (128 * eh + r32) * 256 + cq[ks & 3] + ((ks >> 2) & 1) * 128;
#pragma unroll
        for (int d0 = 0; d0 < 4; ++d0) { const bf16x8 rf = *(LAS const bf16x8*)(rb + d0 * 32 * 256); o[d0] = __builtin_amdgcn_mfma_f32_32x32x16_bf16(qr[ks], rf, o[d0], 0, 0, 0); }
        if (ks & 1) asm volatile("" ::: "memory"); }
    __syncthreads();
#pragma unroll
    for (int j = 0; j < 8; ++j) { const int pi = 8 * wid + j, row = 2 * pi + (lane >> 5), c16 = (lane & 24) | ((lane & 7) ^ (row & 7));
        RO_DMA(Kc + (size_t)row * 256 + c16 * 8, pi * 1024); }
#pragma unroll
    for (int j = 0; j < 8; ++j) { const int pg = 8 * wid + j, t4 = pg >> 4, pi = pg & 15, kh = t4 >> 1, ch = t4 & 1;
        const int s = 2 * pi + (lane >> 5), kk = 8 * (s >> 2) + ((lane & 31) >> 2), key = (kk & ~0xC) | ((kk & 4) << 1) | ((kk & 8) >> 1), col = 32 * (s & 3) + 8 * (lane & 3);
        RO_DMA(Vc + (size_t)(64 * kh + key) * 256 + 128 * ch + col, 65536 + t4 * 16384 + pi * 1024); }
    __syncthreads();
    const int irow = 32 * ib + r32;
#pragma unroll
    for (int kt = 0; kt < 2; ++kt) {
        if (64 * kt <= 32 * ib + 31) {
            f32x16 p0 = f32x16{}, p1 = f32x16{};
            LAS const unsigned char* kb = lds3 + (64 * kt + r32) * 512;
#pragma unroll
            for (int ks = 0; ks < 16; ++ks) { const int co = cq[ks & 3] + (ks >> 2) * 128;
                const bf16x8 k0 = *(LAS const bf16x8*)(kb + co), k1 = *(LAS const bf16x8*)(kb + 32 * 512 + co);
                p0 = __builtin_amdgcn_mfma_f32_32x32x16_bf16(k0, qr[ks], p0, 0, 0, 0); p1 = __builtin_amdgcn_mfma_f32_32x32x16_bf16(k1, qr[ks], p1, 0, 0, 0);
                if ((ks & 3) == 3) asm volatile("" ::: "memory"); }
#pragma unroll
            for (int r = 0; r < 16; ++r) { const int j0 = 64 * kt + att::crow(r, hi), j1 = j0 + 32;
                p0[r] = (j0 <= irow) ? p0[r] * __builtin_amdgcn_exp2f(-(float)(j0 + 1) * lg2) : 0.f;
                p1[r] = (j1 <= irow) ? p1[r] * __builtin_amdgcn_exp2f(-(float)(j1 + 1) * lg2) : 0.f; }
            bf16x8 pa0, pa1, pa2, pa3;
#define PK4(P, B_, OUT) do { unsigned a0 = cvtpk(P[B_ + 0], P[B_ + 1]), a1 = cvtpk(P[B_ + 2], P[B_ + 3]); unsigned b0 = cvtpk(P[B_ + 4], P[B_ + 5]), b1 = cvtpk(P[B_ + 6], P[B_ + 7]); \
        auto r0 = __builtin_amdgcn_permlane32_swap(a0, b0, false, false); auto r1 = __builtin_amdgcn_permlane32_swap(a1, b1, false, false); \
        u32x4 w = {r0[0], r1[0], r0[1], r1[1]}; OUT = __builtin_bit_cast(bf16x8, w); } while (0)
            PK4(p0, 0, pa0); PK4(p0, 8, pa1); PK4(p1, 0, pa2); PK4(p1, 8, pa3);
#undef PK4
            const int vb0 = (int)(uintptr_t)lds + 65536 + (kt * 2 + eh) * 16384 + att::v_rd_base(lane);
            att::pv_tile<0, false>(o, vb0, pa0, pa1, pa2, pa3, true);
        }
    }
#undef RO_DMA
    LAS float* part = (LAS float*)(lds3 + LDS_MISC + 1024);
    float sq[16];
#pragma unroll
    for (int r = 0; r < 16; ++r) { float s = (o[0][r] * o[0][r] + o[1][r] * o[1][r]) + (o[2][r] * o[2][r] + o[3][r] * o[3][r]);
        s += __shfl_xor(s, 1); s += __shfl_xor(s, 2); s += __shfl_xor(s, 4); s += __shfl_xor(s, 8); s += __shfl_xor(s, 16); sq[r] = s;
        if (r32 == 0) part[wid * 32 + att::crow(r, hi)] = s; }
    __syncthreads();
    LAS float* stg = (LAS float*)(lds3 + wid * 16384);
#pragma unroll
    for (int r = 0; r < 16; ++r) { const int il = 32 * ib + att::crow(r, hi); const float tot = sq[r] + part[(wid ^ 1) * 32 + att::crow(r, hi)];
        const float xi = __builtin_amdgcn_exp2f((float)(il + 1) * lg2);
        const float sc = xi * __builtin_amdgcn_rsqf(tot * (1.0f / 256.0f) * xi * xi + NORM_EPS);
#pragma unroll
        for (int d0 = 0; d0 < 4; ++d0) stg[att::crow(r, hi) * 128 + 32 * d0 + r32] = o[d0][r] * sc;
        if ((r & 3) == 3) asm volatile("" ::: "memory"); }
    LDS_WAIT(); asm volatile("" ::: "memory");
    const bf16_t* RG = (const bf16_t*)(ws + WS_RG); bf16_t* X2 = (bf16_t*)(ws + WS_X2);
#pragma unroll
    for (int i = 0; i < 8; ++i) { const int row = 4 * i + (lane >> 4), ch = lane & 15;
        const f32x4 y0 = *(LAS const f32x4*)(stg + row * 128 + 8 * ch), y1 = *(LAS const f32x4*)(stg + row * 128 + 8 * ch + 4);
        const size_t tk = (size_t)b * 4096 + 128 * cc + 32 * ib + row; const int col = h * 256 + 128 * eh + 8 * ch;
        f32x4 g0, g1; pg8::unpack8(*(const u32x4*)(RG + tk * 1024 + col), g0, g1);
        *(u32x4*)(X2 + tk * 2048 + 1024 + col) = pg8::pack8f(y0 * g0, y1 * g1); if (i & 1) asm volatile("" ::: "memory"); }
    __syncthreads();
}
__device__ __forceinline__ void final_norm(const Params& P, int gw, int NGW, int lane) {
    const float* ss2 = (const float*)(P.ws + WS_SS2); const bf16_t* H2 = (const bf16_t*)(P.ws + WS_H2B);
    f32x4 g[8];
#pragma unroll
    for (int j = 0; j < 8; ++j) g[j] = ((const f32x4*)P.gf)[64 * j + lane];
    for (int m = gw; m < MTOK; m += NGW) { const float rs = 1.0f / sqrtf(ss2[m] * (1.0f / 2048.0f) + NORM_EPS); f32x4* row = (f32x4*)(P.out + (size_t)m * DM) + lane; const u32x2* hr = (const u32x2*)(H2 + (size_t)m * DM) + lane;
#pragma unroll
        for (int j = 0; j < 8; ++j) { const u32x2 w = hr[64 * j]; f32x4 v; v[0] = __uint_as_float(w.x << 16); v[1] = __uint_as_float(w.x & 0xffff0000u); v[2] = __uint_as_float(w.y << 16); v[3] = __uint_as_float(w.y & 0xffff0000u);
            row[64 * j] = v * rs * g[j]; } }
}

__global__ void __launch_bounds__(512, 2) mega(Params P) {
    extern __shared__ __attribute__((aligned(16))) unsigned char lds[];
    cg::grid_group grid = cg::this_grid();
    for (int u = threadIdx.x; u < 64; u += 512) ((LAS unsigned*)(lds + LDS_MISC))[u] = 0u;
    __syncthreads();
    XcdBarrier bar = xcd_barrier_post((unsigned*)(P.ws + WS_CTL) + 4096, (volatile LAS unsigned*)((LAS unsigned char*)lds + LDS_MISC) + 8);
#define GRID_BAR() xcd_barrier(bar)
    LAS unsigned char* lds3 = (LAS unsigned char*)lds;
    unsigned char* ws = P.ws;
    const int G = gridDim.x;
#define PHASE_IDS() int tid = threadIdx.x; asm volatile("" : "+v"(tid)); const int lane = tid & 63, wave = __builtin_amdgcn_readfirstlane(tid >> 6), gw = blockIdx.x * 8 + wave, NGW = G * 8; (void)lane; (void)gw; (void)NGW
    typedef pg8::bf16_t pb;

    p0_prologue(P, lds3);
    if (P.ws == nullptr) grid.sync();
    GRID_BAR();
    {
        {   pg8::Gemm g{(const pb*)(ws + WS_XN), (const pb*)(ws + WS_WIN), MTOK, NBF, DM}; pg8::StaticOrder S; S.init(MTOK, NBF, G, (int)blockIdx.x);
            pg8::EpiProj E{ws};
            pg8::gemm_phase<pg8::EpiProj, pg8::StaticOrder, false, true>(lds3, g, S, E); }
        {
            pg8::Gemm g{(const pb*)(ws + WS_XN8), (const pb*)(ws + WS_W8), MTOK, NF8, DM / 2}; pg8::StaticOrder S; S.init(MTOK, NF8, G, (int)blockIdx.x);
            pg8::EpiGateSig E{ws};
            pg8::gemm_phase<pg8::EpiGateSig, pg8::StaticOrder, false, true>(lds3, g, S, E); }
        { PHASE_IDS(); for (int ti = blockIdx.x; ti < 256; ti += G) { meta_tile(ti, ws, lds3, lane, wave); __syncthreads(); } }
    }
    GRID_BAR();
    {   PHASE_IDS(); unsigned* ctr = (unsigned*)(ws + WS_CTL); volatile LAS int* slot = (volatile LAS int*)(lds3 + LDS_MISC);
        constexpr int NRET = 32, NTOT = NRET + 512;
        typedef __hip_bfloat16 hb;
        const float lam = expf(wave_sum(P.lq1[lane] * P.lk1[lane] + P.lq1[lane + 64] * P.lk1[lane + 64])) - expf(wave_sum(P.lq2[lane] * P.lk2[lane] + P.lq2[lane + 64] * P.lk2[lane + 64])) + 0.2f;
#define DEQUEUE(dst) do { __syncthreads(); if (tid == 0) *slot = (int)atomicAdd(ctr, 1u); __syncthreads(); dst = __builtin_amdgcn_readfirstlane(*slot); } while (0)
        int idx; DEQUEUE(idx);
        unsigned* done = (unsigned*)(ws + WS_CTL) + 1024;
        while (idx < NRET) { ret_state_item(idx, ws, lds3);
            asm volatile("s_waitcnt vmcnt(0)" ::: "memory"); __syncthreads();
            if (tid == 0) { __builtin_amdgcn_fence(__ATOMIC_RELEASE, "agent"); asm volatile("s_waitcnt vmcnt(0)" ::: "memory"); (void)__hip_atomic_fetch_add(done + 16 * (idx >> 1), 1u, __ATOMIC_RELAXED, __HIP_MEMORY_SCOPE_AGENT); }
            DEQUEUE(idx); }
        constexpr int NALL = NRET + 512 + 512;
        while (idx < NALL) {
            const int j_ = idx - (NRET + 256), t3 = j_ < 0 ? 1 : j_ % 3, q3 = j_ < 0 ? 0 : j_ / 3;
            if (t3 == 1) {
                const int i_ = j_ < 0 ? idx - NRET : 256 + q3, qb = 31 - (i_ >> 4), bh = i_ & 15, b_ = bh >> 2, h_ = bh & 3;
                const hb* Qs = (const hb*)(ws + WS_Q) + ((size_t)(bh * 2) * KVROWS + 16 + 128 * qb) * 128; const hb* Ks = (const hb*)(ws + WS_K) + (size_t)(bh * 2) * KVROWS * 128; const hb* Vs = (const hb*)(ws + WS_V) + (size_t)(bh * 2) * KVROWS * 128;
                att2::unit(Qs, Qs + (size_t)KVROWS * 128, Ks, Ks + (size_t)KVROWS * 128, Vs, Vs + (size_t)KVROWS * 128,
                           (unsigned short*)(ws + WS_X2) + ((size_t)b_ * 4096 + 128 * qb) * 2048 + h_ * 256, lam, 16 + 128 * qb, 2 * qb + 3, lds);
            } else {
                const int it = 2 * q3 + (t3 >> 1);
                if (tid == 0) { while (__hip_atomic_load(done + 16 * (it >> 5), __ATOMIC_RELAXED, __HIP_MEMORY_SCOPE_AGENT) < 2u) __builtin_amdgcn_s_sleep(2);
                    __builtin_amdgcn_fence(__ATOMIC_ACQUIRE, "agent"); asm volatile("s_waitcnt vmcnt(0)" ::: "memory"); }
                __syncthreads();
                ret_out_item(it, ws, lds, lds3);
            }
            DEQUEUE(idx);
        }
#undef DEQUEUE
    }
    GRID_BAR();
    {   pg8::Gemm g{(const pb*)(ws + WS_X2), (const pb*)(ws + WS_WCAT), MTOK, DM, DM}; pg8::StaticOrder S; S.init(MTOK, DM, G, (int)blockIdx.x);
        pg8::EpiMerge E{(const pb*)(ws + WS_GA), (const pb*)(ws + WS_GR), (pb*)(ws + WS_MERGED)};
        pg8::gemm_phase<pg8::EpiMerge, pg8::StaticOrder, false, true>(lds3, g, S, E); }
    GRID_BAR();
    {
        const bool conv_first = !((blockIdx.x >> 3) & 1);
        if (conv_first) convert_mlp_weights(P, lds3);
        {   pg8::Gemm g{(const pb*)(ws + WS_MERGED), (const pb*)(ws + WS_WO), MTOK, DM, DM}; pg8::StaticOrder S; S.init(MTOK, DM, G, (int)blockIdx.x);
            pg8::EpiResid<false> E{(const void*)P.x, (pb*)(ws + WS_H1B), (float*)(ws + WS_SS1)};
            pg8::gemm_phase<pg8::EpiResid<false>, pg8::StaticOrder, false, true>(lds3, g, S, E); }
        if (!conv_first) convert_mlp_weights(P, lds3); }
    GRID_BAR();
    {   pg8::Gemm g{(const pb*)(ws + WS_H1B), (const pb*)(ws + WS_WUP), MTOK, DFF, DM}; pg8::StaticOrder S; S.init(MTOK, DFF, G, (int)blockIdx.x);
        pg8::EpiUp E{(const float*)(ws + WS_SS1), (pb*)(ws + WS_HID)};
        pg8::gemm_phase<pg8::EpiUp, pg8::StaticOrder, false, true>(lds3, g, S, E); }
    GRID_BAR();
    {   pg8::Gemm g{(const pb*)(ws + WS_HID), (const pb*)(ws + WS_WDN), MTOK, DM, DFF}; pg8::StaticOrder S; S.init(MTOK, DM, G, (int)blockIdx.x);
        pg8::EpiResid<true> E{(const void*)(ws + WS_H1B), (pb*)(ws + WS_H2B), (float*)(ws + WS_SS2)};
        pg8::gemm_phase<pg8::EpiResid<true>, pg8::StaticOrder, false, true>(lds3, g, S, E); }
    GRID_BAR();
    { PHASE_IDS(); final_norm(P, gw, NGW, lane); }
}

extern "C" void kernel_launch(void* const* d_in, const int* in_sizes, int n_in, void* d_out, int out_size, void* d_ws, size_t ws_size, hipStream_t stream) {
    static int grid_blocks = 0;
    if (!grid_blocks) {
        if (n_in != 16 || in_sizes[0] != MTOK * DM || out_size != MTOK * DM || ws_size < WS_END) { fprintf(stderr, "kernel_launch: unexpected shapes (n_in %d, in0 %d, out %d, ws %zu)\n", n_in, n_in > 0 ? in_sizes[0] : -1, out_size, ws_size); grid_blocks = -1; return; }
        int dev = 0, cus = 0, per_cu = 0;
        (void)hipGetDevice(&dev);
        (void)hipDeviceGetAttribute(&cus, hipDeviceAttributeMultiprocessorCount, dev);
        (void)hipFuncSetAttribute((const void*)mega, hipFuncAttributeMaxDynamicSharedMemorySize, LDS_BYTES);
        (void)hipOccupancyMaxActiveBlocksPerMultiprocessor(&per_cu, (const void*)mega, 512, LDS_BYTES);
        if (per_cu < 1) per_cu = 1;
        grid_blocks = cus * per_cu;
    }
    if (grid_blocks < 0) return;
    (void)hipMemsetAsync((char*)d_ws + WS_CTL, 0, 65536, stream);
    Params p{};
    p.x = (const float*)d_in[0]; p.meta = (const float*)d_in[1]; p.g1 = (const float*)d_in[2]; p.w_in = (const float*)d_in[3];
    p.lq1 = (const float*)d_in[4]; p.lk1 = (const float*)d_in[5]; p.lq2 = (const float*)d_in[6]; p.lk2 = (const float*)d_in[7];
    p.subg = (const float*)d_in[8]; p.w_pa = (const float*)d_in[9]; p.w_pr = (const float*)d_in[10]; p.w_o = (const float*)d_in[11];
    p.g2 = (const float*)d_in[12]; p.w_up = (const float*)d_in[13]; p.w_dn = (const float*)d_in[14]; p.gf = (const float*)d_in[15];
    p.out = (float*)d_out; p.ws = (unsigned char*)d_ws;
    void* args[] = {&p};
    hipError_t e = hipLaunchCooperativeKernel((const void*)mega, dim3(grid_blocks), dim3(512), args, LDS_BYTES, stream);
    if (e != hipSuccess) fprintf(stderr, "cooperative launch failed: %s (grid %d)\n", hipGetErrorString(e), grid_blocks);
}
```

```cpp
#include <hip/hip_runtime.h>
#include <hip/hip_bf16.h>
#include <hip/hip_cooperative_groups.h>
#include <cstdio>
#include <cstdint>
namespace cg = cooperative_groups;

constexpr int NB = 4, SEQ = 4096, DM = 2048, NMETA = 16, MTOK = NB * SEQ, INW = 11264, DFF = 8192;
constexpr int KVROWS = 4160;
constexpr int RKROWS = 4224;
constexpr float NORM_EPS = 1e-6f;
constexpr int LDS_BYTES = 147456;
constexpr int LDS_MISC = 143360;

constexpr size_t MiB = 1u << 20;
constexpr size_t SZ_QKV = (size_t)32 * KVROWS * 128 * 2;
constexpr size_t SZ_RK = (size_t)16 * RKROWS * 256 * 2;
constexpr size_t WS_CTL = 0, WS_MISC = 1 * MiB;
constexpr size_t WS_DAC = WS_MISC, WS_DAS = WS_DAC + (size_t)4112 * 64 * 4, WS_RTC = WS_DAS + (size_t)4112 * 64 * 4, WS_RTS = WS_RTC + (size_t)4112 * 128 * 4;
constexpr size_t WS_SS1 = WS_RTS + (size_t)4112 * 128 * 4, WS_SS2 = WS_SS1 + 65536, WS_XNM = WS_SS2 + 65536, WS_MISC_END = WS_XNM + 65536;
constexpr size_t WS_WCAT = 8 * MiB, WS_WO = 16 * MiB;
constexpr size_t WS_GA = 24 * MiB, WS_H1B = 24 * MiB;
constexpr size_t WS_GR = 88 * MiB, WS_WUP = 88 * MiB, WS_WDN = 120 * MiB;
constexpr size_t WS_Q = 152 * MiB, WS_K = WS_Q + SZ_QKV, WS_V = WS_K + SZ_QKV;
constexpr size_t WS_RQ = WS_V + SZ_QKV;
constexpr size_t WS_RK = WS_RQ + 32 * MiB;
constexpr size_t WS_RV = WS_RK + SZ_RK;
constexpr size_t WS_RG = WS_RV + SZ_RK;
constexpr int NBF = 6144, NF8 = INW - NBF;
constexpr size_t WS_WIN = WS_RG + 32 * MiB;
constexpr size_t WS_W8 = WS_WIN + (size_t)NBF * DM * 2;
constexpr size_t WS_XN = WS_W8 + (size_t)NF8 * DM;
constexpr size_t WS_XN8 = WS_XN + (size_t)MTOK * DM * 2;
constexpr size_t WS_X2 = WS_WIN;
constexpr size_t WS_RT = WS_X2 + 64 * MiB, WS_MERGED = WS_RT;
constexpr size_t WS_HID = 152 * MiB;
constexpr size_t WS_H2B = WS_HID + 256 * MiB;
constexpr size_t WS_END = WS_XN8 + (size_t)MTOK * DM;
static_assert(WS_MISC_END <= WS_WCAT && WS_GA + 64 * MiB == WS_GR && WS_GR + 64 * MiB == WS_Q && WS_RG == (size_t)(347.5 * 1048576.0) && WS_WIN == (size_t)(379.5 * 1048576.0) && WS_END <= 512 * MiB
              && WS_H2B + 64 * MiB <= WS_END && WS_X2 + 64 * MiB == WS_RT && WS_RT + 64 * MiB <= WS_END && WS_HID + 256 * MiB <= WS_END, "d_ws map");

typedef unsigned short bf16_t;

__device__ __forceinline__ float dpp_xor1(float v) { return __builtin_bit_cast(float, __builtin_amdgcn_update_dpp(0, __builtin_bit_cast(int, v), 0xB1, 0xF, 0xF, true)); }
__device__ __forceinline__ float sum16_all(float s) {
    s += __builtin_bit_cast(float, __builtin_amdgcn_update_dpp(0, __builtin_bit_cast(int, s), 0xB1, 0xF, 0xF, true));
    s += __builtin_bit_cast(float, __builtin_amdgcn_update_dpp(0, __builtin_bit_cast(int, s), 0x4E, 0xF, 0xF, true));
    s += __builtin_bit_cast(float, __builtin_amdgcn_update_dpp(0, __builtin_bit_cast(int, s), 0x141, 0xF, 0xF, true));
    s += __builtin_bit_cast(float, __builtin_amdgcn_update_dpp(0, __builtin_bit_cast(int, s), 0x140, 0xF, 0xF, true));
    return s; }
__device__ __forceinline__ float sum32_all(float s) {
    s = sum16_all(s); const auto rr = __builtin_amdgcn_permlane16_swap(__float_as_uint(s), __float_as_uint(s), false, false);
    const unsigned a_ = rr[0], b_ = rr[1]; return __uint_as_float(a_) + __uint_as_float(b_); }
__device__ __forceinline__ float sum64_all(float s) {
    s = sum32_all(s); const auto rr = __builtin_amdgcn_permlane32_swap(__float_as_uint(s), __float_as_uint(s), false, false);
    const unsigned a_ = rr[0], b_ = rr[1]; return __uint_as_float(a_) + __uint_as_float(b_); }
namespace pg8 {
#define PG8_LAS __attribute__((address_space(3)))
typedef unsigned short bf16_t;
typedef short bf16x8 __attribute__((ext_vector_type(8)));
typedef float f32x4 __attribute__((ext_vector_type(4)));
typedef unsigned u32x4 __attribute__((ext_vector_type(4)));
constexpr int BM = 256, BK = 64, HALF = 128, HTB = HALF * BK * 2  , STAGE_BYTES = 8 * HTB, NXCD = 8, WGM = 8;

__host__ __device__ __forceinline__ int lds_byte(int r, int c) { const int st = (r >> 4) * 2 + (c >> 5), rr = r & 15, cc = c & 31, ob = rr * 64 + cc * 2; return st * 1024 + (ob ^ (((ob >> 9) & 1) << 5)); }
__host__ __device__ __forceinline__ void stage_rc(int b, int& R, int& C) { const int st = b / 1024, sb = b % 1024, swz = sb ^ (((sb >> 9) & 1) << 5); R = (st >> 1) * 16 + swz / 64; C = (st & 1) * 32 + (swz % 64) / 2; }
__host__ __device__ __forceinline__ int perm32(int rho) { const int n = rho >> 4, i = rho & 15; return 8 * (i >> 2) + 4 * n + (i & 3); }

struct Unit { int pm, pn; };
struct Gemm { const bf16_t* A; const bf16_t* Bt; int M, N, K; };

struct StaticOrder {
    int nM, nN, nwg, G, c;
    __host__ __device__ void init(int M, int N, int G_, int c_) { nM = M / BM; nN = N / BM; nwg = nM * nN; G = G_; c = c_; }
    __host__ __device__ bool next(int i, Unit& u) const {
        const long L = (long)i * G + c; if (L >= nwg) return false;
        int wgid = (int)L; { const int q = nwg / NXCD, r = nwg % NXCD, xcd = wgid % NXCD, off = wgid / NXCD; wgid = (xcd < r ? xcd * (q + 1) : r * (q + 1) + (xcd - r) * q) + off; }
        const int nig = WGM * nN, gid = wgid / nig, fm = gid * WGM, gsz = (nM - fm) < WGM ? (nM - fm) : WGM;
        u.pm = fm + ((wgid % nig) % gsz); u.pn = (wgid % nig) / gsz; return true;
    }
    __device__ __forceinline__ void a_ready(const Unit&) const {}
    __device__ __forceinline__ void done(const Unit&) const {}
};

typedef int pg8_v8i __attribute__((ext_vector_type(8))); typedef int pg8_v4i __attribute__((ext_vector_type(4)));
__device__ __forceinline__ pg8_v8i pg8_cat8(bf16x8 lo, bf16x8 hi) { const pg8_v4i a = __builtin_bit_cast(pg8_v4i, lo), c = __builtin_bit_cast(pg8_v4i, hi); return __builtin_shufflevector(a, c, 0, 1, 2, 3, 4, 5, 6, 7); }
__device__ __forceinline__ void pg8_mfma8(f32x4& c, pg8_v8i a, pg8_v8i b, int sa, int sb) {
    asm volatile("v_mfma_scale_f32_16x16x128_f8f6f4 %0, %1, %2, %0, %3, %4 op_sel_hi:[0,0,0]" : "+v"(c) : "v"(a), "v"(b), "v"(sa), "v"(sb)); }
template <class Epi, class Sched, bool ALIGN_EPI = false, bool SP2 = false>
__device__ __forceinline__ void gemm_phase(PG8_LAS unsigned char* lds, const Gemm g, const Sched& S, const Epi& E) {
    int tid = threadIdx.x; asm volatile("" : "+v"(tid));
    const int wid = __builtin_amdgcn_readfirstlane(tid >> 6), lane = tid & 63, wr = wid >> 2, wc = wid & 3, fr = lane & 15, fq = lane >> 4;
    const int K = g.K, nt = K / BK;
    unsigned voffA[2], voffB[2];
#pragma unroll
    for (int i = 0; i < 2; ++i) { int R, C; stage_rc(tid * 16 + i * 8192, R, C); const int Rb = Epi::PERM ? ((R & ~31) + perm32(R & 31)) : R;
        voffA[i] = (unsigned)(R * K + C) * 2u; voffB[i] = (unsigned)(Rb * K + C) * 2u; }
    const size_t kstep = (size_t)(BK * 2);
    const size_t hstep = (size_t)HALF * K * 2;
    const size_t tstep = 2 * hstep;
    const unsigned ldsw = (unsigned)wid * 1024u;
    const int aoff = lds_byte(wr * 64 + fr, fq * 8), boff = lds_byte(wc * 32 + fr, fq * 8);
#define PG8_SA(b, h) (((b) * 2 + (h)) * HTB)
#define PG8_SB(b, h) ((4 + (b) * 2 + (h)) * HTB)
#define PG8_STAGE(bufoff, gbase, voff) do { _Pragma("unroll") for (int _i = 0; _i < 2; ++_i) \
        __builtin_amdgcn_global_load_lds((const unsigned*)((const char*)(gbase) + (voff)[_i]), (PG8_LAS unsigned*)(lds + (bufoff) + ldsw + _i * 8192), 16, 0, 0); } while (0)
#define PG8_LDA(dst, b, h) do { _Pragma("unroll") for (int m = 0; m < 4; ++m) _Pragma("unroll") for (int k = 0; k < 2; ++k) dst[m][k] = *(const PG8_LAS bf16x8*)(lds + PG8_SA(b, h) + aoff + m * 2048 + k * 1024); } while (0)
#define PG8_LDB(dst, b, h) do { _Pragma("unroll") for (int n = 0; n < 2; ++n) _Pragma("unroll") for (int k = 0; k < 2; ++k) dst[n][k] = *(const PG8_LAS bf16x8*)(lds + PG8_SB(b, h) + boff + n * 2048 + k * 1024); } while (0)
#define PG8_MMA(ai, bj, At, Bt) do { __builtin_amdgcn_s_setprio(1); \
        if constexpr (Epi::FP8) { const int sclw_ = 0x7a7a7a7a, scla_ = 0x7f7f7f7f;   \
            _Pragma("unroll") for (int m = 0; m < 4; ++m) _Pragma("unroll") for (int n = 0; n < 2; ++n) \
                pg8_mfma8(acc[ai][bj][m][n], pg8_cat8(Bt[n][0], Bt[n][1]), pg8_cat8(At[m][0], At[m][1]), sclw_, scla_); } \
        else { _Pragma("unroll") for (int m = 0; m < 4; ++m) _Pragma("unroll") for (int n = 0; n < 2; ++n) _Pragma("unroll") for (int k = 0; k < 2; ++k) \
            acc[ai][bj][m][n] = __builtin_amdgcn_mfma_f32_16x16x32_bf16(Bt[n][k], At[m][k], acc[ai][bj][m][n], 0, 0, 0); } \
        __builtin_amdgcn_s_setprio(0); } while (0)
#define PG8_WAIT_V(n) asm volatile("s_waitcnt vmcnt(" #n ")" ::: "memory")
#define PG8_WAIT_L(n) asm volatile("s_waitcnt lgkmcnt(" #n ")" ::: "memory")
#define PG8_BAR __builtin_amdgcn_s_barrier()
#define PG8_SCHED __builtin_amdgcn_sched_barrier(0)
    Unit cur, nxt; int ui = 0;
    if (!S.next(0, cur)) return;
    f32x4 acc[2][2][4][2];
#pragma unroll
    for (int a = 0; a < 2; ++a)
#pragma unroll
        for (int b = 0; b < 2; ++b)
#pragma unroll
            for (int m = 0; m < 4; ++m)
#pragma unroll
                for (int n = 0; n < 2; ++n) acc[a][b][m][n] = (f32x4){0.f, 0.f, 0.f, 0.f};
    bf16x8 At[4][2], B0[2][2], B1[2][2];
    const char* cA = (const char*)g.A + (size_t)cur.pm * tstep; const char* cB = (const char*)g.Bt + (size_t)cur.pn * tstep;
    S.a_ready(cur);
    if constexpr (SP2) {
        PG8_STAGE(PG8_SB(0, 0), cB, voffB); PG8_STAGE(PG8_SB(0, 1), cB + hstep, voffB); PG8_STAGE(PG8_SA(0, 0), cA, voffA); PG8_STAGE(PG8_SA(0, 1), cA + hstep, voffA);
        if (wr == 1) PG8_BAR;
        PG8_WAIT_V(2); PG8_BAR;
        PG8_STAGE(PG8_SB(1, 0), cB + kstep, voffB); PG8_STAGE(PG8_SA(1, 0), cA + kstep, voffA); PG8_STAGE(PG8_SB(1, 1), cB + hstep + kstep, voffB);
        PG8_WAIT_V(6); PG8_BAR;
    } else {
        PG8_STAGE(PG8_SB(0, 0), cB, voffB); PG8_STAGE(PG8_SA(0, 0), cA, voffA); PG8_STAGE(PG8_SB(0, 1), cB + hstep, voffB); PG8_STAGE(PG8_SA(0, 1), cA + hstep, voffA);
        if (wr == 1) PG8_BAR;
        PG8_WAIT_V(4); PG8_BAR;
        PG8_STAGE(PG8_SB(1, 0), cB + kstep, voffB); PG8_STAGE(PG8_SA(1, 0), cA + kstep, voffA); PG8_STAGE(PG8_SB(1, 1), cB + hstep + kstep, voffB);
        PG8_WAIT_V(6); PG8_BAR;
    }
    for (;;) {
        const bool has_next = S.next(ui + 1, nxt);
        const char* nA = has_next ? (const char*)g.A + (size_t)nxt.pm * tstep : cA; const char* nB = has_next ? (const char*)g.Bt + (size_t)nxt.pn * tstep : cB;
        for (int t = 0; t < nt; t += 2) {
            if constexpr (Epi::MIDHOOK) { if (t == (nt >> 1)) E.mid(acc, cur, wr, wc, fr, fq); }
            const bool last = (t == nt - 2);
            const char* a1 = cA + (size_t)(t + 1) * kstep;
            const char* a2 = last ? nA : cA + (size_t)(t + 2) * kstep; const char* b2 = last ? nB : cB + (size_t)(t + 2) * kstep;
            const char* a3 = a2 + kstep; const char* b3 = b2 + kstep;
            if (last && has_next) S.a_ready(nxt);
            if constexpr (SP2) {
            PG8_LDB(B0, 0, 0); PG8_LDB(B1, 0, 1); PG8_SCHED; PG8_LDA(At, 0, 0); PG8_STAGE(PG8_SA(1, 1), a1 + hstep, voffA);
            PG8_WAIT_V(8); PG8_WAIT_L(0); PG8_BAR; PG8_MMA(0, 0, At, B0); PG8_MMA(0, 1, At, B1); PG8_BAR; PG8_SCHED;
            PG8_LDA(At, 0, 1); PG8_STAGE(PG8_SB(0, 0), b2, voffB); PG8_STAGE(PG8_SB(0, 1), b2 + hstep, voffB); PG8_STAGE(PG8_SA(0, 0), a2, voffA);
            PG8_WAIT_V(8); PG8_WAIT_L(0); PG8_BAR; PG8_MMA(1, 0, At, B0); PG8_MMA(1, 1, At, B1); PG8_BAR; PG8_SCHED;
            PG8_LDB(B0, 1, 0); PG8_LDB(B1, 1, 1); PG8_SCHED; PG8_LDA(At, 1, 0); PG8_STAGE(PG8_SA(0, 1), a2 + hstep, voffA);
            PG8_WAIT_V(8); PG8_WAIT_L(0); PG8_BAR; PG8_MMA(0, 0, At, B0); PG8_MMA(0, 1, At, B1); PG8_BAR; PG8_SCHED;
            PG8_LDA(At, 1, 1); PG8_STAGE(PG8_SB(1, 0), b3, voffB); PG8_STAGE(PG8_SB(1, 1), b3 + hstep, voffB); PG8_STAGE(PG8_SA(1, 0), a3, voffA);
            PG8_WAIT_V(8); PG8_WAIT_L(0); PG8_BAR; PG8_MMA(1, 0, At, B0); PG8_MMA(1, 1, At, B1); PG8_BAR; PG8_SCHED;
            } else {
            PG8_LDB(B0, 0, 0); PG8_SCHED; PG8_LDA(At, 0, 0); PG8_STAGE(PG8_SA(1, 1), a1 + hstep, voffA);
            PG8_WAIT_L(8); PG8_BAR; PG8_WAIT_L(0); PG8_MMA(0, 0, At, B0); PG8_BAR; PG8_SCHED;
            PG8_LDB(B1, 0, 1); PG8_STAGE(PG8_SB(0, 0), b2, voffB);
            PG8_BAR; PG8_WAIT_L(0); PG8_MMA(0, 1, At, B1); PG8_BAR;
            PG8_LDA(At, 0, 1); PG8_STAGE(PG8_SA(0, 0), a2, voffA);
            PG8_BAR; PG8_WAIT_L(0); PG8_MMA(1, 0, At, B0); PG8_BAR; PG8_SCHED;
            PG8_STAGE(PG8_SB(0, 1), b2 + hstep, voffB);
            PG8_WAIT_V(6); PG8_BAR; PG8_MMA(1, 1, At, B1); PG8_BAR;
            PG8_LDB(B0, 1, 0); PG8_SCHED; PG8_LDA(At, 1, 0); PG8_STAGE(PG8_SA(0, 1), a2 + hstep, voffA);
            PG8_WAIT_L(8); PG8_BAR; PG8_WAIT_L(0); PG8_MMA(0, 0, At, B0); PG8_BAR; PG8_SCHED;
            PG8_LDB(B1, 1, 1); PG8_STAGE(PG8_SB(1, 0), b3, voffB);
            PG8_BAR; PG8_WAIT_L(0); PG8_MMA(0, 1, At, B1); PG8_BAR;
            PG8_LDA(At, 1, 1); PG8_STAGE(PG8_SA(1, 0), a3, voffA);
            PG8_BAR; PG8_WAIT_L(0); PG8_MMA(1, 0, At, B0); PG8_BAR; PG8_SCHED;
            PG8_STAGE(PG8_SB(1, 1), b3 + hstep, voffB);
            PG8_WAIT_V(6); PG8_BAR; PG8_MMA(1, 1, At, B1); PG8_BAR;
            }
        }
        if constexpr (ALIGN_EPI) { if (wr == 0) PG8_BAR; }
        if constexpr (Epi::FP8) asm volatile("s_nop 15\n\ts_nop 15");
        if constexpr (!Epi::AFTER_DRAIN) { E(acc, cur, wr, wc, fr, fq); S.done(cur); }
        if (!has_next) break;
#pragma unroll
        for (int a = 0; a < 2; ++a)
#pragma unroll
            for (int b = 0; b < 2; ++b)
#pragma unroll
                for (int m = 0; m < 4; ++m)
#pragma unroll
                    for (int n = 0; n < 2; ++n) acc[a][b][m][n] = (f32x4){0.f, 0.f, 0.f, 0.f};
        cur = nxt; cA = nA; cB = nB; ++ui;
        if constexpr (ALIGN_EPI) { if (wr == 1) PG8_BAR; }
    }
    PG8_WAIT_V(0);
    if constexpr (!ALIGN_EPI) { if (wr == 0) PG8_BAR; }
    PG8_BAR;
    if constexpr (Epi::AFTER_DRAIN) { E.fused(acc, cur, wr, wc, fr, fq, lds, wid, lane); S.done(cur); }
#undef PG8_SA
#undef PG8_SB
#undef PG8_STAGE
#undef PG8_LDA
#undef PG8_LDB
#undef PG8_MMA
#undef PG8_WAIT_V
#undef PG8_WAIT_L
#undef PG8_BAR
#undef PG8_SCHED
}
}
namespace pg8 {
__device__ __forceinline__ unsigned cvt_pk_bf16(float lo, float hi) { typedef __bf16 cvb2_t __attribute__((ext_vector_type(2))); typedef float cvf2_t __attribute__((ext_vector_type(2))); const cvf2_t v_ = {lo, hi}; return __builtin_bit_cast(unsigned, __builtin_convertvector(v_, cvb2_t)); }
__device__ __forceinline__ u32x4 pack8f(f32x4 a, f32x4 b) { u32x4 w; w.x = cvt_pk_bf16(a[0], a[1]); w.y = cvt_pk_bf16(a[2], a[3]); w.z = cvt_pk_bf16(b[0], b[1]); w.w = cvt_pk_bf16(b[2], b[3]); return w; }
__device__ __forceinline__ void unpack8(u32x4 w, f32x4& a, f32x4& b) {
    a[0] = __uint_as_float(w.x << 16); a[1] = __uint_as_float(w.x & 0xffff0000u); a[2] = __uint_as_float(w.y << 16); a[3] = __uint_as_float(w.y & 0xffff0000u);
    b[0] = __uint_as_float(w.z << 16); b[1] = __uint_as_float(w.z & 0xffff0000u); b[2] = __uint_as_float(w.w << 16); b[3] = __uint_as_float(w.w & 0xffff0000u); }
__device__ __forceinline__ float sigm(float x) { return __builtin_amdgcn_rcpf(1.f + __builtin_amdgcn_exp2f(-1.4426950408889634f * x)); }
__device__ __forceinline__ f32x4 opq4(f32x4 v) { asm volatile("" : "+v"(v)); return v; }
__device__ __forceinline__ f32x4 sigm4(f32x4 v) { f32x4 o; o[0] = sigm(v[0]); o[1] = sigm(v[1]); o[2] = sigm(v[2]); o[3] = sigm(v[3]); return o; }
#define EPI_ENTER() asm volatile("" : "+v"(fr), "+v"(fq)); const int rowb = u.pm * BM + wr * 64 + fr
#define EPI_BATCH(ai, mp) int rb_ = rowb + (ai) * HALF + (mp) * 32; asm volatile("" : "+v"(rb_))
#define EPI_FOR_BATCH _Pragma("unroll") for (int ai = 0; ai < 2; ++ai) _Pragma("unroll") for (int mp = 0; mp < 2; ++mp)
#define EPI_FENCE() asm volatile("" ::: "memory")

struct EpiProj {
    static constexpr bool PERM = true, AFTER_DRAIN = false, MIDHOOK = false, FP8 = false;
    unsigned char* ws;
    __device__ __forceinline__ void operator()(const f32x4 (&acc)[2][2][4][2], const Unit& u, int wr, int wc, int fr, int fq) const {
        EPI_ENTER(); const int pn = u.pn, cw = wc * 32 + 8 * fq;
        if (pn < 8) {
            bf16_t* base = (bf16_t*)(ws + (pn < 4 ? WS_Q : WS_K)); const int h = pn & 3; const float* daC = (const float*)(ws + WS_DAC); const float* daS = (const float*)(ws + WS_DAS);
            const int toff = 16 * wc + 4 * fq; f32x4 cn[2], sn[2];
#define EPJ_QK_LD(ai_, mp_) do { int rq_ = rowb + (ai_) * HALF + (mp_) * 32; asm volatile("" : "+v"(rq_)); _Pragma("unroll") for (int k = 0; k < 2; ++k) { const int pq_ = 16 + ((rq_ + 16 * k) & 4095); \
                cn[k] = *(const f32x4*)(daC + pq_ * 64 + toff); sn[k] = *(const f32x4*)(daS + pq_ * 64 + toff); } } while (0)
            EPJ_QK_LD(0, 0);
            EPI_FOR_BATCH { EPI_BATCH(ai, mp); f32x4 c[2], s[2]; int pos[2], b[2];
#pragma unroll
                for (int k = 0; k < 2; ++k) { const int row = rb_ + 16 * k; b[k] = row >> 12; pos[k] = 16 + (row & 4095); c[k] = cn[k]; s[k] = sn[k]; }
                if (ai * 2 + mp < 3) EPJ_QK_LD((ai * 2 + mp + 1) >> 1, (ai * 2 + mp + 1) & 1);
#pragma unroll
                for (int k = 0; k < 2; ++k)
#pragma unroll
                    for (int bj = 0; bj < 2; ++bj) { const f32x4 x1 = acc[ai][bj][2 * mp + k][0], x2 = acc[ai][bj][2 * mp + k][1];
                        *(u32x4*)(base + ((size_t)((b[k] * 4 + h) * 2 + bj) * KVROWS + pos[k]) * 128 + cw) = pack8f(x1 * c[k] - x2 * s[k], x2 * c[k] + x1 * s[k]); }
                EPI_FENCE(); }
#undef EPJ_QK_LD
        } else if (pn < 12) {
            const int h = pn - 8; bf16_t* V = (bf16_t*)(ws + WS_V);
            EPI_FOR_BATCH { EPI_BATCH(ai, mp);
#pragma unroll
                for (int k = 0; k < 2; ++k) { const int row = rb_ + 16 * k, b = row >> 12, pos = 16 + (row & 4095);
#pragma unroll
                    for (int bj = 0; bj < 2; ++bj) *(u32x4*)(V + ((size_t)((b * 4 + h) * 2 + bj) * KVROWS + pos) * 128 + cw) = pack8f(acc[ai][bj][2 * mp + k][0], acc[ai][bj][2 * mp + k][1]); }
                EPI_FENCE(); }
        } else if (pn < 20) {
            const bool isk = pn >= 16; const int h = pn & 3; const float sc = isk ? 0.0625f : 1.f; bf16_t* RK = (bf16_t*)(ws + WS_RK); bf16_t* RQ = (bf16_t*)(ws + WS_RQ); const float* rtC = (const float*)(ws + WS_RTC); const float* rtS = (const float*)(ws + WS_RTS);
            f32x4 cn[2][2], sn[2][2];
#define EPJ_R_LD(ai_, mp_) do { int rq_ = rowb + (ai_) * HALF + (mp_) * 32; asm volatile("" : "+v"(rq_)); _Pragma("unroll") for (int k = 0; k < 2; ++k) { const int pq_ = 16 + ((rq_ + 16 * k) & 4095); \
                _Pragma("unroll") for (int bj = 0; bj < 2; ++bj) { const int d0 = 64 * bj + 16 * wc + 4 * fq; cn[k][bj] = *(const f32x4*)(rtC + pq_ * 128 + d0); sn[k][bj] = *(const f32x4*)(rtS + pq_ * 128 + d0); } } } while (0)
            EPJ_R_LD(0, 0);
            EPI_FOR_BATCH { EPI_BATCH(ai, mp); f32x4 c[2][2], s[2][2]; bf16_t* dst[2];
#pragma unroll
                for (int k = 0; k < 2; ++k) { const int row = rb_ + 16 * k, b = row >> 12, t = row & 4095;
                    dst[k] = isk ? RK + ((size_t)(b * 4 + h) * RKROWS + 128 + t) * 256 + cw : RQ + ((size_t)(b * 4 + h) * 4096 + t) * 256 + cw;
#pragma unroll
                    for (int bj = 0; bj < 2; ++bj) { c[k][bj] = cn[k][bj]; s[k][bj] = sn[k][bj]; } }
                if (ai * 2 + mp < 3) EPJ_R_LD((ai * 2 + mp + 1) >> 1, (ai * 2 + mp + 1) & 1);
#pragma unroll
                for (int k = 0; k < 2; ++k)
#pragma unroll
                    for (int bj = 0; bj < 2; ++bj) { const f32x4 x1 = acc[ai][bj][2 * mp + k][0] * sc, x2 = acc[ai][bj][2 * mp + k][1] * sc;
                        *(u32x4*)(dst[k] + bj * HALF) = pack8f(x1 * c[k][bj] - x2 * s[k][bj], x2 * c[k][bj] + x1 * s[k][bj]); }
                EPI_FENCE(); }
#undef EPJ_R_LD
        } else if (pn < 24) {
            const int h = pn - 20; bf16_t* RV = (bf16_t*)(ws + WS_RV);
            EPI_FOR_BATCH { EPI_BATCH(ai, mp);
#pragma unroll
                for (int k = 0; k < 2; ++k) { const int row = rb_ + 16 * k, b = row >> 12, t = row & 4095;
#pragma unroll
                    for (int bj = 0; bj < 2; ++bj) *(u32x4*)(RV + ((size_t)(b * 4 + h) * RKROWS + 128 + t) * 256 + bj * HALF + cw) = pack8f(acc[ai][bj][2 * mp + k][0], acc[ai][bj][2 * mp + k][1]); }
                EPI_FENCE(); }
        }
    }
};
struct EpiGateSig {
    static constexpr bool PERM = true, AFTER_DRAIN = false, MIDHOOK = false, FP8 = true;
    unsigned char* ws;
    __device__ __forceinline__ void operator()(const f32x4 (&acc)[2][2][4][2], const Unit& u, int wr, int wc, int fr, int fq) const {
        EPI_ENTER(); const int pn = u.pn, cw = wc * 32 + 8 * fq;
        if (pn < 4) {
            bf16_t* RG = (bf16_t*)(ws + WS_RG);
            EPI_FOR_BATCH { EPI_BATCH(ai, mp);
#pragma unroll
                for (int k = 0; k < 2; ++k) { const int row = rb_ + 16 * k;
#pragma unroll
                    for (int bj = 0; bj < 2; ++bj) { const f32x4 a = opq4(acc[ai][bj][2 * mp + k][0]), b2 = opq4(acc[ai][bj][2 * mp + k][1]);
                        *(u32x4*)(RG + (size_t)row * 1024 + pn * 256 + bj * HALF + cw) = pack8f(a * sigm4(a), b2 * sigm4(b2)); } }
                EPI_FENCE(); }
        } else {
            const bool isa = pn < 12; bf16_t* base = (bf16_t*)(ws + (isa ? WS_GA : WS_GR)); const int ct = ((pn - 4) & 7) * 256;
            EPI_FOR_BATCH { EPI_BATCH(ai, mp);
#pragma unroll
                for (int k = 0; k < 2; ++k) { const int row = rb_ + 16 * k;
#pragma unroll
                    for (int bj = 0; bj < 2; ++bj) *(u32x4*)(base + (size_t)row * 2048 + ct + bj * HALF + cw) = pack8f(sigm4(opq4(acc[ai][bj][2 * mp + k][0])), sigm4(opq4(acc[ai][bj][2 * mp + k][1]))); }
                EPI_FENCE(); }
        }
    }
};
struct EpiMerge {
    static constexpr bool PERM = true, AFTER_DRAIN = false, MIDHOOK = true, FP8 = false;
    const bf16_t* GA; const bf16_t* GR; bf16_t* O;
    __device__ __forceinline__ void mid(f32x4 (&acc)[2][2][4][2], const Unit& u, int wr, int wc, int fr, int fq) const {
        EPI_ENTER(); const int cb = u.pn * BM + wc * 32 + 8 * fq;
        EPI_FOR_BATCH { EPI_BATCH(ai, mp); u32x4 ga[2][2], gr[2][2];
#pragma unroll
            for (int k = 0; k < 2; ++k)
#pragma unroll
                for (int bj = 0; bj < 2; ++bj) { const size_t ro = (size_t)(rb_ + 16 * k) * 2048 + cb + bj * HALF; ga[k][bj] = *(const u32x4*)(GA + ro); gr[k][bj] = *(const u32x4*)(GR + ro); }
#pragma unroll
            for (int k = 0; k < 2; ++k)
#pragma unroll
                for (int bj = 0; bj < 2; ++bj) { f32x4 a0, a1, r0, r1; unpack8(ga[k][bj], a0, a1); unpack8(gr[k][bj], r0, r1);
#pragma unroll
                    for (int j = 0; j < 4; ++j) { acc[ai][bj][2 * mp + k][0][j] *= a0[j] * __builtin_amdgcn_rcpf(fmaxf(r0[j], 1e-30f)); acc[ai][bj][2 * mp + k][1][j] *= a1[j] * __builtin_amdgcn_rcpf(fmaxf(r1[j], 1e-30f)); } }
            EPI_FENCE(); }
    }
    __device__ __forceinline__ void operator()(const f32x4 (&acc)[2][2][4][2], const Unit& u, int wr, int wc, int fr, int fq) const {
        EPI_ENTER(); const int cb = u.pn * BM + wc * 32 + 8 * fq;
        EPI_FOR_BATCH { EPI_BATCH(ai, mp); u32x4 gr[2][2];
#pragma unroll
            for (int k = 0; k < 2; ++k)
#pragma unroll
                for (int bj = 0; bj < 2; ++bj) gr[k][bj] = *(const u32x4*)(GR + (size_t)(rb_ + 16 * k) * 2048 + cb + bj * HALF);
#pragma unroll
            for (int k = 0; k < 2; ++k)
#pragma unroll
                for (int bj = 0; bj < 2; ++bj) { f32x4 r0, r1; unpack8(gr[k][bj], r0, r1);
                    *(u32x4*)(O + (size_t)(rb_ + 16 * k) * 2048 + cb + bj * HALF) = pack8f(acc[ai][bj][2 * mp + k][0] * r0, acc[ai][bj][2 * mp + k][1] * r1); }
            EPI_FENCE(); }
    }
};
template <bool RESBF> struct EpiResid {
    static constexpr bool PERM = true, AFTER_DRAIN = false, MIDHOOK = false, FP8 = false;
    const void* res; bf16_t* hb; float* ss;
    __device__ __forceinline__ void operator()(const f32x4 (&acc)[2][2][4][2], const Unit& u, int wr, int wc, int fr, int fq) const {
        EPI_ENTER(); const int cb = u.pn * BM + wc * 32 + 8 * fq;
        EPI_FOR_BATCH { EPI_BATCH(ai, mp); f32x4 r0[2][2], r1[2][2];
#pragma unroll
            for (int k = 0; k < 2; ++k)
#pragma unroll
                for (int bj = 0; bj < 2; ++bj) { const size_t ro = (size_t)(rb_ + 16 * k) * 2048 + cb + bj * HALF;
                    if (RESBF) unpack8(*(const u32x4*)((const bf16_t*)res + ro), r0[k][bj], r1[k][bj]);
                    else { r0[k][bj] = *(const f32x4*)((const float*)res + ro); r1[k][bj] = *(const f32x4*)((const float*)res + ro + 4); } }
#pragma unroll
            for (int k = 0; k < 2; ++k) { const int row = rb_ + 16 * k; float s = 0.f;
#pragma unroll
                for (int bj = 0; bj < 2; ++bj) { const f32x4 o0 = acc[ai][bj][2 * mp + k][0] + r0[k][bj], o1 = acc[ai][bj][2 * mp + k][1] + r1[k][bj];
                    *(u32x4*)(hb + (size_t)row * 2048 + cb + bj * HALF) = pack8f(o0, o1);
                    s += (o0[0] * o0[0] + o0[1] * o0[1]) + (o0[2] * o0[2] + o0[3] * o0[3]) + (o1[0] * o1[0] + o1[1] * o1[1]) + (o1[2] * o1[2] + o1[3] * o1[3]); }
                s += __shfl_xor(s, 16); s += __shfl_xor(s, 32);
                if (fq == 0) atomicAdd(ss + row, s); }
            EPI_FENCE(); }
    }
};
struct EpiUp {
    static constexpr bool PERM = true, AFTER_DRAIN = false, MIDHOOK = false, FP8 = false;
    const float* ss; bf16_t* Hd;
    __device__ __forceinline__ void operator()(const f32x4 (&acc)[2][2][4][2], const Unit& u, int wr, int wc, int fr, int fq) const {
        EPI_ENTER(); const int cb = u.pn * BM + wc * 32 + 8 * fq;
        float sv[2][4];
#pragma unroll
        for (int ai = 0; ai < 2; ++ai)
#pragma unroll
            for (int m = 0; m < 4; ++m) sv[ai][m] = ss[rowb + ai * HALF + m * 16];
        EPI_FOR_BATCH { EPI_BATCH(ai, mp);
#pragma unroll
            for (int k = 0; k < 2; ++k) { const int row = rb_ + 16 * k; const float rs = __builtin_amdgcn_rsqf(sv[ai][2 * mp + k] * (1.0f / 2048.0f) + NORM_EPS);
#pragma unroll
                for (int bj = 0; bj < 2; ++bj) { f32x4 a = acc[ai][bj][2 * mp + k][0] * rs, b2 = acc[ai][bj][2 * mp + k][1] * rs;
#pragma unroll
                    for (int j = 0; j < 4; ++j) { a[j] = fmaxf(a[j], 0.f); a[j] *= a[j]; b2[j] = fmaxf(b2[j], 0.f); b2[j] *= b2[j]; }
                    const u32x4 pk_ = pack8f(a, b2); *(u32x4*)(Hd + (size_t)row * DFF + cb + bj * HALF) = pk_;
                    } }
            EPI_FENCE(); }
    }
};

}
namespace att {
constexpr int D = 128, SQ = 4096, SKV = KVROWS, H = 1, HKV = 1, QOFF = 0, WINDOW = 1 << 20;
constexpr float THR = 8.f;
constexpr bool WSKIP = false;
constexpr float SCALE = 0.08838834764831845f;
constexpr int NW = 8, QBLK = 32, KVBLK = 64, QB = NW * QBLK;
constexpr int SHM_V = KVBLK * D * 2, SHM_K = KVBLK * D * 2;

using bf16 = __hip_bfloat16;
typedef short bf16x8 __attribute__((ext_vector_type(8)));
typedef short s16x4 __attribute__((ext_vector_type(4)));
typedef float f32x16 __attribute__((ext_vector_type(16)));
typedef float f32x4 __attribute__((ext_vector_type(4)));
typedef unsigned u32x4 __attribute__((ext_vector_type(4)));
template <class A, class Bt> struct same_t { static constexpr bool v = false; };
template <class A> struct same_t<A, A> { static constexpr bool v = true; };

#define KSWZ(row, colB) ((row) * 256 + ((colB) ^ (((row) & 7) << 4)))
#define SBAR() __builtin_amdgcn_sched_barrier(0)
__device__ __forceinline__ int v_st(int k, int c) { const int kk = (k & ~0xC) | ((k & 4) << 1) | ((k & 8) >> 1); return ((kk >> 3) * 4 + (c >> 5)) * 512 + ((kk & 7) * 32 + (c & 31)) * 2; }
__device__ __forceinline__ int v_rd_base(int lane) { return ((lane & 3) << 3) | (((lane >> 2) & 3) << 6) | (((lane >> 4) & 1) << 5) | (((lane >> 5) & 1) << 8); }
constexpr int v_rd_off(int d0, int ks, int half) { return d0 * 512 + ks * 4096 + half * 2048; }
__device__ __forceinline__ int crow(int r, int hi) { return (r & 3) + 8 * (r >> 2) + 4 * hi; }
__device__ __forceinline__ unsigned cvtpk(float lo, float hi) {
    typedef __bf16 cvb2_t __attribute__((ext_vector_type(2))); typedef float cvf2_t __attribute__((ext_vector_type(2))); const cvf2_t v_ = {lo, hi}; unsigned r = __builtin_bit_cast(unsigned, __builtin_convertvector(v_, cvb2_t)); asm volatile("" : "+v"(r)); return r;
}
__device__ __forceinline__ bf16x8 pack8(f32x4 a, f32x4 b) {
    u32x4 w = {cvtpk(a[0], a[1]), cvtpk(a[2], a[3]), cvtpk(b[0], b[1]), cvtpk(b[2], b[3])};
    return *reinterpret_cast<bf16x8*>(&w);
}
template <class T> __device__ __forceinline__ bf16x8 load8(const T* p) {
    if constexpr (same_t<T, float>::v) { return pack8(*(const f32x4*)p, *(const f32x4*)(p + 4)); }
    else { return *reinterpret_cast<const bf16x8*>(p); }
}
template <int VB, bool SK>
__device__ __forceinline__ void pv_tile(f32x16* o, int vb0, bf16x8 pa0, bf16x8 pa1, bf16x8 pa2, bf16x8 pa3, bool act) {
    if (SK && !act) return;
#define TRRD(dst, off) asm volatile("ds_read_b64_tr_b16 %0, %1 offset:%2" : "=&v"(dst) : "v"(vb0), "i"(off) : "memory")
#define PV_D0(d0) do { s16x4 l0, l1, l2, l3, h0, h1, h2, h3; constexpr int b_ = VB * SHM_V + v_rd_off(d0, 0, 0);     \
        TRRD(l0, b_); TRRD(h0, b_ + 2048); TRRD(l1, b_ + 4096); TRRD(h1, b_ + 6144); TRRD(l2, b_ + 8192); TRRD(h2, b_ + 10240); TRRD(l3, b_ + 12288); TRRD(h3, b_ + 14336); \
        asm volatile("s_waitcnt lgkmcnt(0)" ::: "memory"); SBAR();                 \
        o[d0] = __builtin_amdgcn_mfma_f32_32x32x16_bf16(pa0, (bf16x8){l0[0], l0[1], l0[2], l0[3], h0[0], h0[1], h0[2], h0[3]}, o[d0], 0, 0, 0);   \
        o[d0] = __builtin_amdgcn_mfma_f32_32x32x16_bf16(pa1, (bf16x8){l1[0], l1[1], l1[2], l1[3], h1[0], h1[1], h1[2], h1[3]}, o[d0], 0, 0, 0);   \
        o[d0] = __builtin_amdgcn_mfma_f32_32x32x16_bf16(pa2, (bf16x8){l2[0], l2[1], l2[2], l2[3], h2[0], h2[1], h2[2], h2[3]}, o[d0], 0, 0, 0);   \
        o[d0] = __builtin_amdgcn_mfma_f32_32x32x16_bf16(pa3, (bf16x8){l3[0], l3[1], l3[2], l3[3], h3[0], h3[1], h3[2], h3[3]}, o[d0], 0, 0, 0); } while (0)
    PV_D0(0); PV_D0(1); PV_D0(2); PV_D0(3);
#undef PV_D0
#undef TRRD
}

}
namespace att2 {
using att::bf16; using att::bf16x8; using att::f32x16; using att::u32x4; using att::s16x4;
constexpr int KB_OFF = 0, VB_OFF = 32768, HM_OFF = 98304, F_OFF = 100352, AL_OFF = 133120;
constexpr int LDS_END = AL_OFF + 8 * 256;
static_assert(LDS_END <= LDS_MISC, "attention scratch below the control words");
constexpr float C2 = 1.4426950408889634f * att::SCALE;
#define A2_KSWZ(row, colB) ((row) * 256 + ((colB) ^ (((row) & 7) << 4)))
typedef __attribute__((address_space(3))) unsigned char* lp_t;
__device__ __forceinline__ void pass(const bf16* Qb, const bf16* Kb, const bf16* V0, const bf16* V1, int P0, int NT, unsigned char* lds, f32x16 (&o)[4]) {
    int tid = threadIdx.x; asm volatile("" : "+v"(tid));
    const int wid = __builtin_amdgcn_readfirstlane(tid >> 6), lane = tid & 63, r32 = lane & 31, hi = lane >> 5, g = wid & 3, r = wid >> 2;
    const lp_t L = (lp_t)lds;
    lp_t krd[4];
#pragma unroll
    for (int q = 0; q < 4; ++q) krd[q] = L + KB_OFF + r * 8192 + A2_KSWZ(r32, (q * 16 + hi * 8) * 2);
    const int vrd = (int)(uintptr_t)lds + VB_OFF + r * 16384 + att::v_rd_base(lane);
    const lp_t hmw = L + HM_OFF + (wid * 32 + r32) * 4, hmr = L + HM_OFF + ((wid ^ 4) * 32 + r32) * 4;
    const lp_t fxw = L + F_OFF + (wid * 64 + lane) * 32, fxr = L + F_OFF + ((wid ^ 4) * 64 + lane) * 32;
    float* al = (float*)(lds + AL_OFF) + wid * 64;
    const bf16* kgs[2]; const bf16* vgs[2][2];
#pragma unroll
    for (int j = 0; j < 2; ++j) { const int pi = 2 * wid + j, row = 4 * pi + (lane >> 4), ch = (lane & 15) ^ (row & 7); kgs[j] = Kb + (size_t)row * 128 + ch * 8;
        const int s = 2 * pi + (lane >> 5), kk = 8 * (s >> 2) + ((lane & 31) >> 2), key = (kk & ~0xC) | ((kk & 4) << 1) | ((kk & 8) >> 1), col = 32 * (s & 3) + 8 * (lane & 3);
        vgs[0][j] = V0 + (size_t)key * 128 + col; vgs[1][j] = V1 + (size_t)key * 128 + col; }
    const lp_t dmw = L + wid * 2048;
#define A2_DMA(src_, dst_) __builtin_amdgcn_global_load_lds((const unsigned*)(src_), (__attribute__((address_space(3))) unsigned*)(dst_), 16, 0, 0)
#define A2_DMAK(t_, S_) do { A2_DMA(kgs[0] + (size_t)(t_) * 8192, dmw + KB_OFF + (S_) * 16384); A2_DMA(kgs[1] + (size_t)(t_) * 8192, dmw + KB_OFF + (S_) * 16384 + 1024); } while (0)
#define A2_DMAV(t_, S_) do { A2_DMA(vgs[0][0] + (size_t)(t_) * 8192, dmw + VB_OFF + (S_) * 32768); A2_DMA(vgs[0][1] + (size_t)(t_) * 8192, dmw + VB_OFF + (S_) * 32768 + 1024); \
        A2_DMA(vgs[1][0] + (size_t)(t_) * 8192, dmw + VB_OFF + (S_) * 32768 + 16384); A2_DMA(vgs[1][1] + (size_t)(t_) * 8192, dmw + VB_OFF + (S_) * 32768 + 16384 + 1024); } while (0)
    bf16x8 qr[8];
#pragma unroll
    for (int d0 = 0; d0 < 8; ++d0) qr[d0] = *(const bf16x8*)(Qb + (size_t)(32 * g + r32) * 128 + d0 * 16 + hi * 8);
    float m_reg = -1e30f, l_reg = 0.f, pmA = 0.f, pmB = 0.f; f32x16 pA, pB = f32x16{}; u32x4 fA0, fA1, fB0, fB1;
#pragma unroll
    for (int i = 0; i < 4; ++i) o[i] = f32x16{};
    fA0 = fA1 = fB0 = fB1 = (u32x4){0u, 0u, 0u, 0u};
    const int qpos = P0 + 32 * g + r32;
#define A2_QK(P_, S_) do { P_ = f32x16{}; \
        _Pragma("unroll") for (int d0 = 0; d0 < 8; ++d0) { const bf16x8 kf_ = *(__attribute__((address_space(3))) const bf16x8*)(krd[d0 & 3] + (S_) * 16384 + (d0 >> 2) * 128); P_ = __builtin_amdgcn_mfma_f32_32x32x16_bf16(kf_, qr[d0], P_, 0, 0, 0); } } while (0)
#define A2_MASK_HM(P_, PM_, t_, PAR_) do { const int kb_ = 64 * (t_) + 32 * r; \
        if (kb_ + 31 > P0 + 32 * g) { const int dq_ = qpos - kb_ - 4 * hi; _Pragma("unroll") for (int i = 0; i < 16; ++i) { const int c_ = (i & 3) + 8 * (i >> 2); if (dq_ - c_ < 0) P_[i] = -__builtin_inff(); } } \
        PM_ = fmaxf(fmaxf(P_[0], P_[1]), P_[2]); _Pragma("unroll") for (int i = 3; i < 15; i += 2) PM_ = fmaxf(fmaxf(PM_, P_[i]), P_[i + 1]); PM_ = fmaxf(PM_, P_[15]); \
        { auto rr_ = __builtin_amdgcn_permlane32_swap(__float_as_uint(PM_), __float_as_uint(PM_), false, false); PM_ = fmaxf(__uint_as_float(rr_[0]), __uint_as_float(rr_[1])); } \
        if (hi == 0) *(__attribute__((address_space(3))) float*)(hmw + (PAR_) * 1024) = PM_; } while (0)
#define A2_TRRD(dst, off) asm volatile("ds_read_b64_tr_b16 %0, %1 offset:%2" : "=&v"(dst) : "v"(vrd), "i"(off) : "memory")
#define A2_RD8(L0, H0, L1, H1, L2, H2, L3, H3, d0, S_) do { constexpr int b_ = (S_) * 32768 + (d0) * 512; \
        A2_TRRD(L0, b_); A2_TRRD(H0, b_ + 2048); A2_TRRD(L1, b_ + 4096); A2_TRRD(H1, b_ + 6144); A2_TRRD(L2, b_ + 8192); A2_TRRD(H2, b_ + 10240); A2_TRRD(L3, b_ + 12288); A2_TRRD(H3, b_ + 14336); } while (0)
#define A2_MM4(L0, H0, L1, H1, L2, H2, L3, H3, d0) do { \
        o[d0] = __builtin_amdgcn_mfma_f32_32x32x16_bf16(pa0_, (bf16x8){L0[0], L0[1], L0[2], L0[3], H0[0], H0[1], H0[2], H0[3]}, o[d0], 0, 0, 0); \
        o[d0] = __builtin_amdgcn_mfma_f32_32x32x16_bf16(pa1_, (bf16x8){L1[0], L1[1], L1[2], L1[3], H1[0], H1[1], H1[2], H1[3]}, o[d0], 0, 0, 0); \
        o[d0] = __builtin_amdgcn_mfma_f32_32x32x16_bf16(pa2_, (bf16x8){L2[0], L2[1], L2[2], L2[3], H2[0], H2[1], H2[2], H2[3]}, o[d0], 0, 0, 0); \
        o[d0] = __builtin_amdgcn_mfma_f32_32x32x16_bf16(pa3_, (bf16x8){L3[0], L3[1], L3[2], L3[3], H3[0], H3[1], H3[2], H3[3]}, o[d0], 0, 0, 0); } while (0)
#define A2_WAIT0() do { asm volatile("s_waitcnt lgkmcnt(0)" ::: "memory"); __builtin_amdgcn_sched_barrier(0); } while (0)
#define A2_PV_ALL(S_, V0_, V1_, V2_, V3_) do { s16x4 xa0, xa1, xa2, xa3, xa4, xa5, xa6, xa7; \
        A2_RD8(xa0, xa1, xa2, xa3, xa4, xa5, xa6, xa7, 0, S_); A2_WAIT0(); A2_MM4(xa0, xa1, xa2, xa3, xa4, xa5, xa6, xa7, 0); V0_; \
        A2_RD8(xa0, xa1, xa2, xa3, xa4, xa5, xa6, xa7, 1, S_); A2_WAIT0(); A2_MM4(xa0, xa1, xa2, xa3, xa4, xa5, xa6, xa7, 1); V1_; \
        A2_RD8(xa0, xa1, xa2, xa3, xa4, xa5, xa6, xa7, 2, S_); A2_WAIT0(); A2_MM4(xa0, xa1, xa2, xa3, xa4, xa5, xa6, xa7, 2); V2_; \
        A2_RD8(xa0, xa1, xa2, xa3, xa4, xa5, xa6, xa7, 3, S_); A2_WAIT0(); A2_MM4(xa0, xa1, xa2, xa3, xa4, xa5, xa6, xa7, 3); V3_; } while (0)
#define A2_PV_SETUP(FO0_, FO1_, PAR_) const u32x4 g0_ = *(__attribute__((address_space(3))) const u32x4*)(fxr + (PAR_) * 16384), g1_ = *(__attribute__((address_space(3))) const u32x4*)(fxr + (PAR_) * 16384 + 16); \
        const bf16x8 pa0_ = __builtin_bit_cast(bf16x8, r ? g0_ : FO0_), pa1_ = __builtin_bit_cast(bf16x8, r ? g1_ : FO1_), pa2_ = __builtin_bit_cast(bf16x8, r ? FO0_ : g0_), pa3_ = __builtin_bit_cast(bf16x8, r ? FO1_ : g1_)
#define A2_EXP(P_, lo_, hi_) do { _Pragma("unroll") for (int i = lo_; i < hi_; ++i) { P_[i] = __builtin_amdgcn_exp2f(fmaf(P_[i], C2, mnL_)); ps_ += P_[i]; } } while (0)
#define A2_PACK(P_, F_, B_) do { unsigned a0 = att::cvtpk(P_[B_ + 0], P_[B_ + 1]), a1 = att::cvtpk(P_[B_ + 2], P_[B_ + 3]), b0 = att::cvtpk(P_[B_ + 4], P_[B_ + 5]), b1 = att::cvtpk(P_[B_ + 6], P_[B_ + 7]); \
        auto r0 = __builtin_amdgcn_permlane32_swap(a0, b0, false, false); auto r1 = __builtin_amdgcn_permlane32_swap(a1, b1, false, false); F_ = (u32x4){r0[0], r1[0], r0[1], r1[1]}; } while (0)
#define A2_RESC(AL_) do { if (__any((AL_) < 1.f)) { if (hi == 0) al[r32] = (AL_); asm volatile("s_waitcnt lgkmcnt(0)" ::: "memory"); \
        _Pragma("unroll") for (int d_ = 0; d_ < 4; ++d_) _Pragma("unroll") for (int i = 0; i < 16; ++i) o[d_][i] *= al[att::crow(i, hi)]; } } while (0)
#define A2_PHASE(FIRST_, t, PAR_, PC_, PMC_, PN_, PMN_, FO0_, FO1_, FN0_, FN1_) do { \
        if ((t) + 2 < NT) A2_DMAK((t) + 2, PAR_);                         \
        A2_DMAV((t), PAR_);                                               \
        float alpha_ = 1.f; { const float pmax_ = fmaxf(PMC_, *(__attribute__((address_space(3))) const float*)(hmr + (PAR_) * 1024)); \
          if (!__builtin_expect(__all((pmax_ - m_reg) * att::SCALE <= att::THR), 1)) { const float mn_ = fmaxf(m_reg, pmax_); alpha_ = __builtin_amdgcn_exp2f((m_reg - mn_) * C2); m_reg = mn_; } } \
        const float mnL_ = -m_reg * C2; float ps_ = 0.f; \
        if ((t) + 1 < NT) A2_QK(PN_, 1 - (PAR_)); \
        if (FIRST_) { A2_EXP(PC_, 0, 16); A2_PACK(PC_, FN0_, 0); A2_PACK(PC_, FN1_, 8); } \
        else { A2_PV_SETUP(FO0_, FO1_, 1 - (PAR_)); \
            A2_PV_ALL(1 - (PAR_), A2_EXP(PC_, 0, 8), A2_EXP(PC_, 8, 16), A2_PACK(PC_, FN0_, 0), A2_PACK(PC_, FN1_, 8)); } \
        A2_RESC(alpha_);                                                  \
        { auto rr_ = __builtin_amdgcn_permlane32_swap(__float_as_uint(ps_), __float_as_uint(ps_), false, false); ps_ = __uint_as_float(rr_[0]) + __uint_as_float(rr_[1]); } \
        l_reg = l_reg * alpha_ + ps_; \
        *(__attribute__((address_space(3))) u32x4*)(fxw + (PAR_) * 16384) = FN0_; *(__attribute__((address_space(3))) u32x4*)(fxw + (PAR_) * 16384 + 16) = FN1_; \
        if ((t) + 1 < NT) { A2_MASK_HM(PN_, PMN_, (t) + 1, 1 - (PAR_)); } \
        __syncthreads(); } while (0)
    A2_DMAK(0, 0);
    if (NT > 1) A2_DMAK(1, 1);
    __syncthreads();
    A2_QK(pA, 0); A2_MASK_HM(pA, pmA, 0, 0);
    __syncthreads();
    A2_PHASE(true, 0, 0, pA, pmA, pB, pmB, fB0, fB1, fA0, fA1);
    for (int t = 1; t < NT; t += 2) {
        A2_PHASE(false, t, 1, pB, pmB, pA, pmA, fA0, fA1, fB0, fB1);
        A2_PHASE(false, t + 1, 0, pA, pmA, pB, pmB, fB0, fB1, fA0, fA1);
    }
    { A2_PV_SETUP(fA0, fA1, 0); A2_PV_ALL(0, (void)0, (void)0, (void)0, (void)0); }
    float* hm = (float*)(lds + HM_OFF);
    if (hi == 0) hm[wid * 32 + r32] = l_reg;
    __syncthreads();
    { const float lt = l_reg + hm[(wid ^ 4) * 32 + r32]; if (hi == 0) al[32 + r32] = lt; }
    asm volatile("s_waitcnt lgkmcnt(0)" ::: "memory");
#pragma unroll
    for (int i = 0; i < 16; ++i) { const float rl = __builtin_amdgcn_rcpf(al[32 + att::crow(i, hi)]);
#pragma unroll
        for (int d0 = 0; d0 < 4; ++d0) o[d0][i] *= rl; }
    __syncthreads();
#undef A2_DMA
#undef A2_DMAK
#undef A2_DMAV
#undef A2_QK
#undef A2_MASK_HM
#undef A2_TRRD
#undef A2_RD8
#undef A2_MM4
#undef A2_WAIT0
#undef A2_PV_ALL
#undef A2_PV_SETUP
#undef A2_EXP
#undef A2_PACK
#undef A2_RESC
#undef A2_PHASE
}

__device__ __forceinline__ void unit(const bf16* Q0, const bf16* Q1, const bf16* K0, const bf16* K1, const bf16* V0, const bf16* V1, unsigned short* Xrow, float lam, int P0, int NT, unsigned char* lds) {
    f32x16 o[4]; unsigned o1p[4][8];
    pass(Q0, K0, V0, V1, P0, NT, lds, o);
#pragma unroll
    for (int d0 = 0; d0 < 4; ++d0)
#pragma unroll
        for (int i = 0; i < 8; ++i) o1p[d0][i] = att::cvtpk(o[d0][2 * i], o[d0][2 * i + 1]);
    pass(Q1, K1, V0, V1, P0, NT, lds, o);
    int tid = threadIdx.x; asm volatile("" : "+v"(tid));
    const int wid = __builtin_amdgcn_readfirstlane(tid >> 6), lane = tid & 63, r32 = lane & 31, hi = lane >> 5, g = wid & 3, r = wid >> 2;
    float* xs = (float*)(lds + HM_OFF);
    float sq[16];
#pragma unroll
    for (int i = 0; i < 16; ++i) { float s = 0.f;
#pragma unroll
        for (int d0 = 0; d0 < 4; ++d0) { const unsigned w = o1p[d0][i >> 1]; const float o1 = __uint_as_float((i & 1) ? (w & 0xffff0000u) : (w << 16)); const float d = o1 - lam * o[d0][i]; o[d0][i] = d; s += d * d; }
        s = sum32_all(s); sq[i] = s;
        if (r32 == 0) xs[wid * 32 + att::crow(i, hi)] = s; }
    __syncthreads();
    unsigned short* Ow = Xrow + (size_t)(32 * g) * 2048 + 128 * r;
#pragma unroll
    for (int i = 0; i < 16; ++i) { const int orow = att::crow(i, hi); const float rs = __builtin_amdgcn_rsqf((sq[i] + xs[(wid ^ 4) * 32 + orow]) * (1.0f / 256.0f) + NORM_EPS);
#pragma unroll
        for (int d0 = 0; d0 < 4; ++d0) { const float v = o[d0][i] * rs; const float vn = dpp_xor1(v);
            if ((r32 & 1) == 0) *(unsigned*)(Ow + (size_t)orow * 2048 + d0 * 32 + r32) = att::cvtpk(v, vn); } }
    __syncthreads();
}
}
#define LAS __attribute__((address_space(3)))
typedef short bf16x8 __attribute__((ext_vector_type(8)));
typedef short v4i16_t __attribute__((ext_vector_type(4)));
typedef float f32x4 __attribute__((ext_vector_type(4)));
typedef float f32x16 __attribute__((ext_vector_type(16)));
typedef unsigned u32x4 __attribute__((ext_vector_type(4)));
typedef unsigned u32x2 __attribute__((ext_vector_type(2)));
#define LDS_WAIT() asm volatile("s_waitcnt lgkmcnt(0)" ::: "memory")
#define XB_TMO      128
#define XB_XCNT(j)  (256  + 64 * (j))
#define XB_XSUB(j)  (1280 + 64 * (j))
#define XB_XGEN(j)  (2304 + 64 * (j))
#define XB_TOP      3328
#define XB_TOPGEN   3392
#define XCD_BAR_WORDS 3456
#define XB_SPIN_CAP (1u << 18)

__device__ __forceinline__ unsigned xb_ld(unsigned* p)              { return __hip_atomic_load(p, __ATOMIC_RELAXED, __HIP_MEMORY_SCOPE_AGENT); }
__device__ __forceinline__ unsigned xb_add(unsigned* p, unsigned v) { return __hip_atomic_fetch_add(p, v, __ATOMIC_RELAXED, __HIP_MEMORY_SCOPE_AGENT); }
__device__ __forceinline__ unsigned xb_xcc_id() { return (unsigned)__builtin_amdgcn_s_getreg((3 << 11) | 20) & 0xFu; }
#define XB_SPIN(cond, bar) do { unsigned _sp = 0; while (cond) { __builtin_amdgcn_s_sleep(1); \
    if ((++_sp & 255u) == 0u) { if (xb_ld(&(bar)[XB_TMO])) break; if (_sp > XB_SPIN_CAP) { atomicAdd(&(bar)[XB_TMO], 1u); break; } } } } while (0)

struct XcdBarrier {
    unsigned* bar; unsigned x;
    volatile LAS unsigned* st;
};

__device__ __forceinline__ XcdBarrier xcd_barrier_post(unsigned* bar, volatile LAS unsigned* st) {
    XcdBarrier b; b.bar = bar; b.x = xb_xcc_id(); b.st = st;
    if (threadIdx.x == 0) (void)xb_add(&bar[XB_XCNT(b.x)], 1u);
    return b;
}
__device__ __forceinline__ void xcd_barrier_complete(unsigned* bar, unsigned x, unsigned& nloc, unsigned& nx) {
    const unsigned G = gridDim.x * gridDim.y * gridDim.z;
    unsigned sum, cnt, mine, sp = 0u;
    for (;;) {
        sum = 0u; cnt = 0u; mine = 0u;
#pragma unroll
        for (unsigned j = 0; j < 16; ++j) { const unsigned c = xb_ld(&bar[XB_XCNT(j)]); sum += c; cnt += (c > 0u) ? 1u : 0u; mine = (j == x) ? c : mine; }
        if (sum == G) break;
        __builtin_amdgcn_s_sleep(1);
        if ((++sp & 255u) == 0u) { if (xb_ld(&bar[XB_TMO])) break; if (sp > XB_SPIN_CAP) { atomicAdd(&bar[XB_TMO], 1u); break; } }
    }
    nloc = mine > 0u ? mine : 1u; nx = cnt > 0u ? cnt : 1u;
}

__device__ __forceinline__ void xcd_barrier(const XcdBarrier& b) {
    asm volatile("s_waitcnt vmcnt(0)" ::: "memory");
    __syncthreads();
    if (threadIdx.x == 0) {
        unsigned* bar = b.bar;
        __builtin_amdgcn_s_waitcnt(0);
        unsigned nloc = b.st[0], nx = b.st[1];
        if (nloc == 0u) { xcd_barrier_complete(bar, b.x, nloc, nx); b.st[0] = nloc; b.st[1] = nx; }
        const unsigned old = xb_add(&bar[XB_XSUB(b.x)], 1u);
        const unsigned gen = old / nloc;
        if (old + 1u == (gen + 1u) * nloc) {
            __builtin_amdgcn_fence(__ATOMIC_RELEASE, "agent");
            asm volatile("s_waitcnt vmcnt(0)" ::: "memory");
            const unsigned og = xb_add(&bar[XB_TOP], 1u);
            const unsigned tg = og / nx;
            if (og + 1u == (tg + 1u) * nx) xb_add(&bar[XB_TOPGEN], 1u);
            else XB_SPIN(xb_ld(&bar[XB_TOPGEN]) == tg, bar);
            __builtin_amdgcn_fence(__ATOMIC_ACQUIRE, "agent");
            xb_add(&bar[XB_XGEN(b.x)], 1u);
            asm volatile("s_waitcnt vmcnt(0)" ::: "memory");
        } else {
            XB_SPIN(xb_ld(&bar[XB_XGEN(b.x)]) == gen, bar);
            __builtin_amdgcn_fence(__ATOMIC_ACQUIRE, "agent");
            asm volatile("s_waitcnt vmcnt(0)" ::: "memory");
        }
    }
    __syncthreads();
}

struct Params {
    const float *x, *meta, *g1, *w_in, *lq1, *lk1, *lq2, *lk2, *subg, *w_pa, *w_pr, *w_o, *g2, *w_up, *w_dn, *gf;
    float* out; unsigned char* ws;
};

__device__ __forceinline__ unsigned cvtpk(float lo, float hi) { typedef __bf16 cvb2_t __attribute__((ext_vector_type(2))); typedef float cvf2_t __attribute__((ext_vector_type(2))); const cvf2_t v_ = {lo, hi}; return __builtin_bit_cast(unsigned, __builtin_convertvector(v_, cvb2_t)); }
__device__ __forceinline__ float bf2f(unsigned short v) { return __uint_as_float((unsigned)v << 16); }
__device__ __forceinline__ unsigned short f2bf(float f) { return (unsigned short)(cvtpk(f, f) & 0xffffu); }
__device__ __forceinline__ float wave_sum(float v) { return sum64_all(v); }
__device__ __forceinline__ float head_lg2(int h) { return h == 0 ? -0.04580368961312479f : h == 1 ? -0.02272007650008353f : h == 2 ? -0.011315313227834146f : -0.005646563141142063f; }

__device__ __forceinline__ int win_dest(int n) {
    if (n < 2048) { const int d = n & 127; return (n & ~127) + 8 * ((d & 63) >> 2) + 4 * (d >> 6) + (d & 3); }
    if (n >= 3072 && n < 5120) { const int o = n - 3072, d = o & 255; return 3072 + (o & ~255) + 8 * ((d & 127) >> 2) + 4 * (d >> 7) + (d & 3); }
    return n;
}
__device__ __forceinline__ unsigned pk4_fp8(float a, float b, float c_, float d) { int w = __builtin_amdgcn_cvt_pk_fp8_f32(a, b, 0, false); w = __builtin_amdgcn_cvt_pk_fp8_f32(c_, d, w, true); return (unsigned)w; }
template <int MODE>
__device__ __forceinline__ void transpose_item(const float* W, int K, int N, bf16_t* WT, const float* g, LAS float* scr, int item, int lane, int ldk = 0, int nbu = 0) {
    if (ldk == 0) ldk = K;
    const int nblk = nbu ? nbu : N / 32, kb = item / nblk, nb = item - kb * nblk, k0 = 64 * kb, n0 = 32 * nb;
#pragma unroll 8
    for (int i = 0; i < 32; ++i) { const int kk = 2 * i + (lane >> 5); float v = W[(size_t)(k0 + kk) * N + n0 + (lane & 31)];
        if (MODE == 0 || MODE == 3) v *= g[k0 + kk];
        if (MODE == 1) v *= g[(k0 + kk) & 255] * 0.8f;
        scr[kk * 33 + (lane & 31)] = v; }
    LDS_WAIT(); asm volatile("" ::: "memory");
    const int c = lane & 7;
#pragma unroll
    for (int j = 0; j < 4; ++j) { const int n = (lane >> 3) + 8 * j; const LAS float* s = scr + (8 * c) * 33 + n;
        u32x4 o; o.x = cvtpk(s[0 * 33], s[1 * 33]); o.y = cvtpk(s[2 * 33], s[3 * 33]); o.z = cvtpk(s[4 * 33], s[5 * 33]); o.w = cvtpk(s[6 * 33], s[7 * 33]);
        const int dest = (MODE == 0) ? win_dest(n0 + n) : (n0 + n);
        *(u32x4*)(WT + (size_t)dest * ldk + k0 + 8 * c) = o; }
    LDS_WAIT(); asm volatile("" ::: "memory");
}
__device__ __forceinline__ void gate8_item(const float* W, unsigned char* W8, const float* g, LAS float* scr, int item, int lane) {
    const int kp = item / (NF8 / 32), nb = item - kp * (NF8 / 32), n0 = NBF + 32 * nb, c = lane & 7;
#pragma unroll 1
    for (int h = 0; h < 2; ++h) { const int k0 = 128 * kp + 64 * h;
#pragma unroll 8
        for (int i = 0; i < 32; ++i) { const int kk = 2 * i + (lane >> 5); scr[kk * 33 + (lane & 31)] = W[(size_t)(k0 + kk) * INW + n0 + (lane & 31)] * g[k0 + kk]; }
        LDS_WAIT(); asm volatile("" ::: "memory");
#pragma unroll
        for (int j = 0; j < 4; ++j) { const int n = (lane >> 3) + 8 * j; const LAS float* s = scr + (8 * c) * 33 + n;
            u32x2 o; o.x = pk4_fp8(s[0 * 33] * 32.f, s[1 * 33] * 32.f, s[2 * 33] * 32.f, s[3 * 33] * 32.f); o.y = pk4_fp8(s[4 * 33] * 32.f, s[5 * 33] * 32.f, s[6 * 33] * 32.f, s[7 * 33] * 32.f);
            *(u32x2*)(W8 + (size_t)(n0 + n - NBF) * DM + k0 + 8 * c) = o; }
        LDS_WAIT(); asm volatile("" ::: "memory"); }
}
__device__ __forceinline__ void rms_row_to_bf16(const float* xrow, bf16_t* orow, int lane, unsigned char* orow8 = nullptr) {
    const f32x4* xr = (const f32x4*)xrow + lane; f32x4 v[8]; float s = 0.f;
#pragma unroll
    for (int j = 0; j < 8; ++j) { v[j] = xr[64 * j]; s += (v[j].x * v[j].x + v[j].y * v[j].y) + (v[j].z * v[j].z + v[j].w * v[j].w); }
    const float rs = 1.0f / sqrtf(wave_sum(s) * (1.0f / 2048.0f) + NORM_EPS);
    u32x2* o8 = (u32x2*)orow + lane;
#pragma unroll
    for (int j = 0; j < 8; ++j) { u32x2 w; w.x = cvtpk(v[j].x * rs, v[j].y * rs); w.y = cvtpk(v[j].z * rs, v[j].w * rs); o8[64 * j] = w; }
    if (orow8) {
        unsigned* o4 = (unsigned*)orow8 + lane;
#pragma unroll
        for (int j = 0; j < 8; ++j) o4[64 * j] = pk4_fp8(v[j].x * rs, v[j].y * rs, v[j].z * rs, v[j].w * rs); }
}
__device__ __forceinline__ void rope_entry(int pos, int i, double rbase, float& c, float& s) {
    double acc = 1.0, bb = rbase;
#pragma unroll
    for (int k = 0; k < 7; ++k) { if (i & (1 << k)) acc *= bb; bb *= bb; }
    const float inv = (float)acc, ang = (float)pos * inv;
    const double x = (double)ang, kq = __builtin_rint(x * 0.63661977236758134308); const int q = (int)kq;
    double r = __builtin_fma(-kq, 1.57079632679489655800e+00, x); r = __builtin_fma(-kq, 6.12323399573676603587e-17, r);
    const double r2 = r * r;
    double sp = r2 * (-2.50521083854417187751e-08) + 2.75573192239858906526e-06; sp = sp * r2 - 1.98412698412698412698e-04; sp = sp * r2 + 8.33333333333333333333e-03; sp = sp * r2 - 1.66666666666666666667e-01;
    const double sn = r + r * r2 * sp;
    double cp = r2 * 2.08767569878680989792e-09 - 2.75573192239858906526e-07; cp = cp * r2 + 2.48015873015873015873e-05; cp = cp * r2 - 1.38888888888888888889e-03; cp = cp * r2 + 4.16666666666666666667e-02; cp = cp * r2 - 0.5;
    const double cs = 1.0 + r2 * cp;
    const int qq = q & 3;
    const double so = (qq == 0) ? sn : (qq == 1) ? cs : (qq == 2) ? -sn : -cs, co = (qq == 0) ? cs : (qq == 1) ? -sn : (qq == 2) ? -cs : sn;
    c = (float)co; s = (float)so;
}
__device__ __forceinline__ void zero_range(unsigned char* p, size_t bytes, int gtid, int gn) {
    u32x4* q = (u32x4*)p; const size_t n = bytes / 16;
    for (size_t i = gtid; i < n; i += gn) q[i] = (u32x4){0u, 0u, 0u, 0u};
}
__device__ __forceinline__ void p0_prologue(const Params& P, LAS unsigned char* lds3) {
    unsigned char* ws = P.ws;
    const int tid = threadIdx.x, lane = tid & 63, wave = __builtin_amdgcn_readfirstlane(tid >> 6);
    const int G = gridDim.x, gw = blockIdx.x * 8 + wave, NGW = G * 8, gtid = blockIdx.x * 512 + tid, gn = G * 512;
    LAS float* scr = (LAS float*)(lds3 + wave * 16384);
    constexpr int I_G8 = (DM / 128) * (NF8 / 32), I_IN = (DM / 64) * (NBF / 32), I_PA = (1024 / 64) * (DM / 32), I_PR = I_PA, I_O = (DM / 64) * (DM / 32);
    constexpr int NITEMS = I_G8 + I_IN + I_PA + I_PR + I_O;
    for (int it = gw; it < NITEMS; it += NGW) {
        int r = it;
        if (r < I_G8) { gate8_item(P.w_in, ws + WS_W8, P.g1, scr, r, lane); continue; } r -= I_G8;
        if (r < I_IN) { transpose_item<0>(P.w_in, DM, INW, (bf16_t*)(ws + WS_WIN), P.g1, scr, r, lane, 0, NBF / 32); continue; } r -= I_IN;
        if (r < I_PA) { transpose_item<1>(P.w_pa, 1024, DM, (bf16_t*)(ws + WS_WCAT), P.subg, scr, r, lane, 2048); continue; } r -= I_PA;
        if (r < I_PR) { transpose_item<2>(P.w_pr, 1024, DM, (bf16_t*)(ws + WS_WCAT) + 1024, nullptr, scr, r, lane, 2048); continue; } r -= I_PR;
        transpose_item<2>(P.w_o, DM, DM, (bf16_t*)(ws + WS_WO), nullptr, scr, r, lane);
    }
    for (int m = gw; m < MTOK + NMETA; m += NGW) {
        if (m < MTOK) rms_row_to_bf16(P.x + (size_t)m * DM, (bf16_t*)(ws + WS_XN) + (size_t)m * DM, lane, ws + WS_XN8 + (size_t)m * DM);
        else rms_row_to_bf16(P.meta + (size_t)(m - MTOK) * DM, (bf16_t*)(ws + WS_XNM) + (size_t)(m - MTOK) * DM, lane);
    }
    {
        float* daC = (float*)(ws + WS_DAC); float* daS = (float*)(ws + WS_DAS); float* rtC = (float*)(ws + WS_RTC); float* rtS = (float*)(ws + WS_RTS);
        for (int e = gtid; e < 4112 * 64; e += gn) { float c, s; rope_entry(e >> 6, e & 63, 0.8659643233600653, c, s); daC[e] = c; daS[e] = s; }
        for (int e = gtid; e < 4112 * 128; e += gn) { float c, s; rope_entry(e >> 7, e & 127, 0.9305720409296990, c, s); rtC[e] = c; rtS[e] = s; }
    }
    zero_range(ws + WS_SS1, 131072, gtid, gn);
    for (int u = 0; u < 32; ++u) {
        zero_range(ws + WS_K + ((size_t)u * KVROWS + 4112) * 256, 48 * 256, gtid, gn);
        zero_range(ws + WS_V + ((size_t)u * KVROWS + 4112) * 256, 48 * 256, gtid, gn);
    }
    for (int u = 0; u < 16; ++u) {
        zero_range(ws + WS_RK + (size_t)u * RKROWS * 512, 112 * 512, gtid, gn);
        zero_range(ws + WS_RV + (size_t)u * RKROWS * 512, 112 * 512, gtid, gn);
    }
}

__device__ __forceinline__ void convert_mlp_weights(const Params& P, LAS unsigned char* lds3) {
    int tid = threadIdx.x; asm volatile("" : "+v"(tid));
    const int lane = tid & 63, wave = __builtin_amdgcn_readfirstlane(tid >> 6), gw = blockIdx.x * 8 + wave, NGW = gridDim.x * 8;
    LAS float* scr = (LAS float*)(lds3 + wave * 16384);
    constexpr int I_UP = (DM / 64) * (DFF / 32), I_DN = (DFF / 64) * (DM / 32);
    for (int it = gw; it < I_UP + I_DN; it += NGW) {
        if (it < I_UP) transpose_item<3>(P.w_up, DM, DFF, (bf16_t*)(P.ws + WS_WUP), P.g2, scr, it, lane);
        else transpose_item<2>(P.w_dn, DFF, DM, (bf16_t*)(P.ws + WS_WDN), nullptr, scr, it - I_UP, lane);
    }
    __syncthreads();
}
__device__ __forceinline__ void meta_tile(int ti, unsigned char* ws, LAS unsigned char* lds3, int lane, int wave) {
    typedef float f32x4v __attribute__((ext_vector_type(4)));
    const int sect = ti >> 6, tj = ti & 63;
    const int nbase = (sect == 0 ? 1024 : sect == 1 ? 2048 : sect == 2 ? 4096 : 5120) + 16 * tj;
    const int c16 = lane & 15, kg = lane >> 4;
    const bf16_t* ap = (const bf16_t*)(ws + WS_XNM) + c16 * 2048 + kg * 8 + 256 * wave;
    const bf16_t* bp = (const bf16_t*)(ws + WS_WIN) + (size_t)(nbase + c16) * 2048 + kg * 8 + 256 * wave;
    f32x4v acc = {0.f, 0.f, 0.f, 0.f};
#pragma unroll
    for (int ks = 0; ks < 8; ++ks) { const bf16x8 a = *(const bf16x8*)(ap + 32 * ks), b = *(const bf16x8*)(bp + 32 * ks); acc = __builtin_amdgcn_mfma_f32_16x16x32_bf16(a, b, acc, 0, 0, 0); }
    LAS f32x4v* red = (LAS f32x4v*)lds3;
    red[wave * 64 + lane] = acc;
    __syncthreads();
    if (wave != 0) return;
#pragma unroll
    for (int w = 1; w < 8; ++w) acc += red[w * 64 + lane];
    const float* daC = (const float*)(ws + WS_DAC); const float* daS = (const float*)(ws + WS_DAS); const float* rtC = (const float*)(ws + WS_RTC); const float* rtS = (const float*)(ws + WS_RTS);
    const int h = tj >> 4;
#pragma unroll
    for (int r = 0; r < 4; ++r) {
        const int pos = 4 * kg + r; const float x = acc[r], xp = __shfl_xor(x, 4);
        if (sect == 0) { const int p = 16 * (tj & 7) + c16, c = (tj >> 3) & 1, d = 4 * (p >> 3) + (p & 3); const float cv = daC[pos * 64 + d], sv = daS[pos * 64 + d];
            const unsigned short o = f2bf(((p >> 2) & 1) ? x * cv + xp * sv : x * cv - xp * sv);
            for (int b = 0; b < NB; ++b) ((bf16_t*)(ws + WS_K))[((size_t)((b * 4 + h) * 2 + c) * KVROWS + pos) * 128 + p] = o;
        } else if (sect == 1) { const int col = 16 * (tj & 7) + c16, vh = (tj >> 3) & 1; const unsigned short o = f2bf(x);
            for (int b = 0; b < NB; ++b) ((bf16_t*)(ws + WS_V))[((size_t)((b * 4 + h) * 2 + vh) * KVROWS + pos) * 128 + col] = o;
        } else if (sect == 2) { const int p = 16 * (tj & 15) + c16, d = 4 * (p >> 3) + (p & 3); const float cv = rtC[pos * 128 + d], sv = rtS[pos * 128 + d];
            const unsigned short o = f2bf((((p >> 2) & 1) ? x * cv + xp * sv : x * cv - xp * sv) * 0.0625f);
            for (int b = 0; b < NB; ++b) ((bf16_t*)(ws + WS_RK))[((size_t)(b * 4 + h) * RKROWS + 112 + pos) * 256 + p] = o;
        } else { const int col = 16 * (tj & 15) + c16; const unsigned short o = f2bf(x);
            for (int b = 0; b < NB; ++b) ((bf16_t*)(ws + WS_RV))[((size_t)(b * 4 + h) * RKROWS + 112 + pos) * 256 + col] = o;
        }
    }
}

__device__ __forceinline__ bf16x8 trfrag(LAS const char* p) {
    const v4i16_t l = __builtin_amdgcn_ds_read_tr16_b64_v4i16((LAS v4i16_t*)p), h = __builtin_amdgcn_ds_read_tr16_b64_v4i16((LAS v4i16_t*)(p + 2048));
    return (bf16x8){l[0], l[1], l[2], l[3], h[0], h[1], h[2], h[3]};
}
__device__ __forceinline__ bf16x8 scale8(bf16x8 v, float f) {
    u32x4 w = __builtin_bit_cast(u32x4, v); f32x4 a, b; pg8::unpack8(w, a, b); a *= f; b *= f; return __builtin_bit_cast(bf16x8, pg8::pack8f(a, b));
}
__device__ __forceinline__ void ret_state_item(int item, unsigned char* ws, LAS unsigned char* lds3) {
    int tid = threadIdx.x; asm volatile("" : "+v"(tid));
    const int wid = __builtin_amdgcn_readfirstlane(tid >> 6), lane = tid & 63, r32 = lane & 31, hi = lane >> 5;
    const int bh = item >> 1, dh = item & 1, h = bh & 3;
    const float lg2 = head_lg2(h), gC = __builtin_amdgcn_exp2f(128.f * lg2);
    const bf16_t* Kp = (const bf16_t*)(ws + WS_RK) + (size_t)bh * RKROWS * 256 + dh * 128;
    const bf16_t* Vp = (const bf16_t*)(ws + WS_RV) + (size_t)bh * RKROWS * 256;
    bf16_t* RTp = (bf16_t*)(ws + WS_RT) + (size_t)bh * 32 * 65536;
    const int sr = tid >> 4, sc = (tid & 15) * 8, st0 = att::v_st(sr, sc), st1 = att::v_st(32 + sr, sc);
    const float z0 = __builtin_amdgcn_exp2f((float)(127 - sr) * lg2), z32 = __builtin_amdgcn_exp2f((float)(95 - sr) * lg2), z64 = __builtin_amdgcn_exp2f((float)(63 - sr) * lg2), z96 = __builtin_amdgcn_exp2f((float)(31 - sr) * lg2);
    bf16x8 sv[8], sk[4];
#define RS_LOAD(c) do { const size_t r0_ = (size_t)(128 * (c) + sr) * 256; \
        _Pragma("unroll") for (int kh = 0; kh < 2; ++kh) { _Pragma("unroll") for (int ch = 0; ch < 2; ++ch) { \
            sv[(kh * 2 + ch) * 2] = *(const bf16x8*)(Vp + r0_ + (size_t)kh * 64 * 256 + ch * 128 + sc); sv[(kh * 2 + ch) * 2 + 1] = *(const bf16x8*)(Vp + r0_ + (size_t)(kh * 64 + 32) * 256 + ch * 128 + sc); } \
            sk[kh * 2] = *(const bf16x8*)(Kp + r0_ + (size_t)kh * 64 * 256 + sc); sk[kh * 2 + 1] = *(const bf16x8*)(Kp + r0_ + (size_t)(kh * 64 + 32) * 256 + sc); } } while (0)
    f32x16 acc[4];
#pragma unroll
    for (int i = 0; i < 4; ++i) acc[i] = f32x16{};
    RS_LOAD(0);
    const int rdb = att::v_rd_base(lane);
    for (int c = 0; c < 32; ++c) {
#pragma unroll
        for (int t4 = 0; t4 < 4; ++t4) { *(LAS bf16x8*)(lds3 + t4 * 16384 + st0) = sv[t4 * 2]; *(LAS bf16x8*)(lds3 + t4 * 16384 + st1) = sv[t4 * 2 + 1]; }
        *(LAS bf16x8*)(lds3 + 4 * 16384 + st0) = scale8(sk[0], z0); *(LAS bf16x8*)(lds3 + 4 * 16384 + st1) = scale8(sk[1], z32);
        *(LAS bf16x8*)(lds3 + 5 * 16384 + st0) = scale8(sk[2], z64); *(LAS bf16x8*)(lds3 + 5 * 16384 + st1) = scale8(sk[3], z96);
        __syncthreads();
        if (c + 1 < 32) RS_LOAD(c + 1);
#pragma unroll
        for (int i = 0; i < 4; ++i) acc[i] *= gC;
        bf16x8 af[8];
#pragma unroll
        for (int ks = 0; ks < 8; ++ks) af[ks] = trfrag((LAS const char*)lds3 + ((ks >> 2) * 2 + (wid >> 2)) * 16384 + rdb + (wid & 3) * 512 + (ks & 3) * 4096);
#pragma unroll
        for (int dt = 0; dt < 4; ++dt)
#pragma unroll
            for (int ks = 0; ks < 8; ++ks) { const bf16x8 bfr = trfrag((LAS const char*)lds3 + (4 + (ks >> 2)) * 16384 + rdb + dt * 512 + (ks & 3) * 4096);
                acc[dt] = __builtin_amdgcn_mfma_f32_32x32x16_bf16(af[ks], bfr, acc[dt], 0, 0, 0); }
        bf16_t* dst = RTp + (size_t)c * 65536 + dh * 128 + r32;
#pragma unroll
        for (int dt = 0; dt < 4; ++dt)
#pragma unroll
            for (int r = 0; r < 16; ++r) dst[(size_t)(32 * wid + att::crow(r, hi)) * 256 + 32 * dt] = f2bf(acc[dt][r]);
        __syncthreads();
    }
#undef RS_LOAD
}
__device__ __forceinline__ void ret_out_item(int item, unsigned char* ws, unsigned char* lds, LAS unsigned char* lds3) {
    int tid = threadIdx.x; asm volatile("" : "+v"(tid));
    const int wid = __builtin_amdgcn_readfirstlane(tid >> 6), lane = tid & 63, r32 = lane & 31, hi = lane >> 5;
    const int bh = item >> 5, cc = item & 31, h = bh & 3, b = bh >> 2, ib = wid >> 1, eh = wid & 1;
    const float lg2 = head_lg2(h);
    const bf16_t* Qc = (const bf16_t*)(ws + WS_RQ) + ((size_t)bh * 4096 + 128 * cc) * 256;
    const bf16_t* Kc = (const bf16_t*)(ws + WS_RK) + ((size_t)bh * RKROWS + 128 + 128 * cc) * 256;
    const bf16_t* Vc = (const bf16_t*)(ws + WS_RV) + ((size_t)bh * RKROWS + 128 + 128 * cc) * 256;
    const bf16_t* RTc = (const bf16_t*)(ws + WS_RT) + ((size_t)bh * 32 + cc) * 65536;
#define RO_DMA(src_, off_) __builtin_amdgcn_global_load_lds((const unsigned*)(src_), (LAS unsigned*)(lds3 + (off_)), 16, 0, 0)
#pragma unroll
    for (int hf = 0; hf < 2; ++hf)
#pragma unroll
        for (int j = 0; j < 8; ++j) { const int pi = 8 * wid + j, e = 4 * pi + (lane >> 4), c16 = (lane & 8) | ((lane & 7) ^ (e & 7));
            RO_DMA(RTc + (size_t)e * 256 + hf * 128 + c16 * 8, hf * 65536 + pi * 1024); }
    bf16x8 qr[16];
#pragma unroll
    for (int ks = 0; ks < 16; ++ks) qr[ks] = *(const bf16x8*)(Qc + (size_t)(32 * ib + r32) * 256 + 16 * ks + 8 * hi);
    f32x16 o[4];
#pragma unroll
    for (int i = 0; i < 4; ++i) o[i] = f32x16{};
    int cq[4];
#pragma unroll
    for (int q = 0; q < 4; ++q) cq[q] = ((2 * q + hi) ^ (r32 & 7)) << 4;
    __syncthreads();
#pragma unroll
    for (int ks = 0; ks < 16; ++ks) { LAS const unsigned char* rb = lds3 + (ks >> 3) * 65536 + (128 * eh + r32) * 256 + cq[ks & 3] + ((ks >> 2) & 1) * 128;
#pragma unroll
        for (int d0 = 0; d0 < 4; ++d0) { const bf16x8 rf = *(LAS const bf16x8*)(rb + d0 * 32 * 256); o[d0] = __builtin_amdgcn_mfma_f32_32x32x16_bf16(qr[ks], rf, o[d0], 0, 0, 0); }
        if (ks & 1) asm volatile("" ::: "memory"); }
    __syncthreads();
#pragma unroll
    for (int j = 0; j < 8; ++j) { const int pi = 8 * wid + j, row = 2 * pi + (lane >> 5), c16 = (lane & 24) | ((lane & 7) ^ (row & 7));
        RO_DMA(Kc + (size_t)row * 256 + c16 * 8, pi * 1024); }
#pragma unroll
    for (int j = 0; j < 8; ++j) { const int pg = 8 * wid + j, t4 = pg >> 4, pi = pg & 15, kh = t4 >> 1, ch = t4 & 1;
        const int s = 2 * pi + (lane >> 5), kk = 8 * (s >> 2) + ((lane & 31) >> 2), key = (kk & ~0xC) | ((kk & 4) << 1) | ((kk & 8) >> 1), col = 32 * (s & 3) + 8 * (lane & 3);
        RO_DMA(Vc + (size_t)(64 * kh + key) * 256 + 128 * ch + col, 65536 + t4 * 16384 + pi * 1024); }
    __syncthreads();
    const int irow = 32 * ib + r32;
#pragma unroll
    for (int kt = 0; kt < 2; ++kt) {
        if (64 * kt <= 32 * ib + 31) {
            f32x16 p0 = f32x16{}, p1 = f32x16{};
            LAS const unsigned char* kb = lds3 + (64 * kt + r32) * 512;
#pragma unroll
            for (int ks = 0; ks < 16; ++ks) { const int co = cq[ks & 3] + (ks >> 2) * 128;
                const bf16x8 k0 = *(LAS const bf16x8*)(kb + co), k1 = *(LAS const bf16x8*)(kb + 32 * 512 + co);
                p0 = __builtin_amdgcn_mfma_f32_32x32x16_bf16(k0, qr[ks], p0, 0, 0, 0); p1 = __builtin_amdgcn_mfma_f32_32x32x16_bf16(k1, qr[ks], p1, 0, 0, 0);
                if ((ks & 3) == 3) asm volatile("" ::: "memory"); }
#pragma unroll
            for (int r = 0; r < 16; ++r) { const int j0 = 64 * kt + att::crow(r, hi), j1 = j0 + 32;
                p0[r] = (j0 <= irow) ? p0[r] * __builtin_amdgcn_exp2f(-(float)(j0 + 1) * lg2) : 0.f;
                p1[r] = (j1 <= irow) ? p1[r] * __builtin_amdgcn_exp2f(-(float)(j1 + 1) * lg2) : 0.f; }
            bf16x8 pa0, pa1, pa2, pa3;
#define PK4(P, B_, OUT) do { unsigned a0 = cvtpk(P[B_ + 0], P[B_ + 1]), a1 = cvtpk(P[B_ + 2], P[B_ + 3]); unsigned b0 = cvtpk(P[B_ + 4], P[B_ + 5]), b1 = cvtpk(P[B_ + 6], P[B_ + 7]); \
        auto r0 = __builtin_amdgcn_permlane32_swap(a0, b0, false, false); auto r1 = __builtin_amdgcn_permlane32_swap(a1, b1, false, false); \
        u32x4 w = {r0[0], r1[0], r0[1], r1[1]}; OUT = __builtin_bit_cast(bf16x8, w); } while (0)
            PK4(p0, 0, pa0); PK4(p0, 8, pa1); PK4(p1, 0, pa2); PK4(p1, 8, pa3);
#undef PK4
            const int vb0 = (int)(uintptr_t)lds + 65536 + (kt * 2 + eh) * 16384 + att::v_rd_base(lane);
            att::pv_tile<0, false>(o, vb0, pa0, pa1, pa2, pa3, true);
        }
    }
#undef RO_DMA
    LAS float* part = (LAS float*)(lds3 + LDS_MISC + 1024);
    float sq[16];
#pragma unroll
    for (int r = 0; r < 16; ++r) { float s = (o[0][r] * o[0][r] + o[1][r] * o[1][r]) + (o[2][r] * o[2][r] + o[3][r] * o[3][r]);
        s = sum32_all(s); sq[r] = s;
        if (r32 == 0) part[wid * 32 + att::crow(r, hi)] = s; }
    __syncthreads();
    LAS float* stg = (LAS float*)(lds3 + wid * 16384);
#pragma unroll
    for (int r = 0; r < 16; ++r) { const int il = 32 * ib + att::crow(r, hi); const float tot = sq[r] + part[(wid ^ 1) * 32 + att::crow(r, hi)];
        const float xi = __builtin_amdgcn_exp2f((float)(il + 1) * lg2);
        const float sc = xi * __builtin_amdgcn_rsqf(tot * (1.0f / 256.0f) * xi * xi + NORM_EPS);
#pragma unroll
        for (int d0 = 0; d0 < 4; ++d0) stg[att::crow(r, hi) * 128 + 32 * d0 + r32] = o[d0][r] * sc;
        if ((r & 3) == 3) asm volatile("" ::: "memory"); }
    LDS_WAIT(); asm volatile("" ::: "memory");
    const bf16_t* RG = (const bf16_t*)(ws + WS_RG); bf16_t* X2 = (bf16_t*)(ws + WS_X2);
#pragma unroll
    for (int i = 0; i < 8; ++i) { const int row = 4 * i + (lane >> 4), ch = lane & 15;
        const f32x4 y0 = *(LAS const f32x4*)(stg + row * 128 + 8 * ch), y1 = *(LAS const f32x4*)(stg + row * 128 + 8 * ch + 4);
        const size_t tk = (size_t)b * 4096 + 128 * cc + 32 * ib + row; const int col = h * 256 + 128 * eh + 8 * ch;
        f32x4 g0, g1; pg8::unpack8(*(const u32x4*)(RG + tk * 1024 + col), g0, g1);
        *(u32x4*)(X2 + tk * 2048 + 1024 + col) = pg8::pack8f(y0 * g0, y1 * g1); if (i & 1) asm volatile("" ::: "memory"); }
    __syncthreads();
}
__device__ __forceinline__ void final_norm(const Params& P, int gw, int NGW, int lane) {
    const float* ss2 = (const float*)(P.ws + WS_SS2); const bf16_t* H2 = (const bf16_t*)(P.ws + WS_H2B);
    f32x4 g[8];
#pragma unroll
    for (int j = 0; j < 8; ++j) g[j] = ((const f32x4*)P.gf)[64 * j + lane];
    for (int m = gw; m < MTOK; m += NGW) { const float rs = 1.0f / sqrtf(ss2[m] * (1.0f / 2048.0f) + NORM_EPS); f32x4* row = (f32x4*)(P.out + (size_t)m * DM) + lane; const u32x2* hr = (const u32x2*)(H2 + (size_t)m * DM) + lane;
#pragma unroll
        for (int j = 0; j < 8; ++j) { const u32x2 w = hr[64 * j]; f32x4 v; v[0] = __uint_as_float(w.x << 16); v[1] = __uint_as_float(w.x & 0xffff0000u); v[2] = __uint_as_float(w.y << 16); v[3] = __uint_as_float(w.y & 0xffff0000u);
            row[64 * j] = v * rs * g[j]; } }
}

__global__ void __launch_bounds__(512, 2) mega(Params P) {
    extern __shared__ __attribute__((aligned(16))) unsigned char lds[];
    cg::grid_group grid = cg::this_grid();
    for (int u = threadIdx.x; u < 64; u += 512) ((LAS unsigned*)(lds + LDS_MISC))[u] = 0u;
    __syncthreads();
    XcdBarrier bar = xcd_barrier_post((unsigned*)(P.ws + WS_CTL) + 4096, (volatile LAS unsigned*)((LAS unsigned char*)lds + LDS_MISC) + 8);
#define GRID_BAR() xcd_barrier(bar)
    LAS unsigned char* lds3 = (LAS unsigned char*)lds;
    unsigned char* ws = P.ws;
    const int G = gridDim.x;
#define PHASE_IDS() int tid = threadIdx.x; asm volatile("" : "+v"(tid)); const int lane = tid & 63, wave = __builtin_amdgcn_readfirstlane(tid >> 6), gw = blockIdx.x * 8 + wave, NGW = G * 8; (void)lane; (void)gw; (void)NGW
    typedef pg8::bf16_t pb;

    p0_prologue(P, lds3);
    if (P.ws == nullptr) grid.sync();
    GRID_BAR();
    {
        {   pg8::Gemm g{(const pb*)(ws + WS_XN), (const pb*)(ws + WS_WIN), MTOK, NBF, DM}; pg8::StaticOrder S; S.init(MTOK, NBF, G, (int)blockIdx.x);
            pg8::EpiProj E{ws};
            pg8::gemm_phase<pg8::EpiProj, pg8::StaticOrder, false, true>(lds3, g, S, E); }
        {
            pg8::Gemm g{(const pb*)(ws + WS_XN8), (const pb*)(ws + WS_W8), MTOK, NF8, DM / 2}; pg8::StaticOrder S; S.init(MTOK, NF8, G, (int)blockIdx.x);
            pg8::EpiGateSig E{ws};
            pg8::gemm_phase<pg8::EpiGateSig, pg8::StaticOrder, false, true>(lds3, g, S, E); }
        { PHASE_IDS(); for (int ti = blockIdx.x; ti < 256; ti += G) { meta_tile(ti, ws, lds3, lane, wave); __syncthreads(); } }
    }
    GRID_BAR();
    {   PHASE_IDS(); unsigned* ctr = (unsigned*)(ws + WS_CTL); volatile LAS int* slot = (volatile LAS int*)(lds3 + LDS_MISC);
        constexpr int NRET = 32, NTOT = NRET + 512;
        typedef __hip_bfloat16 hb;
        const float lam = expf(wave_sum(P.lq1[lane] * P.lk1[lane] + P.lq1[lane + 64] * P.lk1[lane + 64])) - expf(wave_sum(P.lq2[lane] * P.lk2[lane] + P.lq2[lane + 64] * P.lk2[lane + 64])) + 0.2f;
#define DEQUEUE(dst) do { __syncthreads(); if (tid == 0) *slot = (int)atomicAdd(ctr, 1u); __syncthreads(); dst = __builtin_amdgcn_readfirstlane(*slot); } while (0)
        int idx; DEQUEUE(idx);
        unsigned* done = (unsigned*)(ws + WS_CTL) + 1024;
        while (idx < NRET) { ret_state_item(idx, ws, lds3);
            asm volatile("s_waitcnt vmcnt(0)" ::: "memory"); __syncthreads();
            if (tid == 0) { __builtin_amdgcn_fence(__ATOMIC_RELEASE, "agent"); asm volatile("s_waitcnt vmcnt(0)" ::: "memory"); (void)__hip_atomic_fetch_add(done + 16 * (idx >> 1), 1u, __ATOMIC_RELAXED, __HIP_MEMORY_SCOPE_AGENT); }
            DEQUEUE(idx); }
        constexpr int NALL = NRET + 512 + 512;
        while (idx < NALL) {
            const int j_ = idx - (NRET + 256), t3 = j_ < 0 ? 1 : j_ % 3, q3 = j_ < 0 ? 0 : j_ / 3;
            if (t3 == 1) {
                const int i_ = j_ < 0 ? idx - NRET : 256 + q3, qb = 31 - (i_ >> 4), bh = i_ & 15, b_ = bh >> 2, h_ = bh & 3;
                const hb* Qs = (const hb*)(ws + WS_Q) + ((size_t)(bh * 2) * KVROWS + 16 + 128 * qb) * 128; const hb* Ks = (const hb*)(ws + WS_K) + (size_t)(bh * 2) * KVROWS * 128; const hb* Vs = (const hb*)(ws + WS_V) + (size_t)(bh * 2) * KVROWS * 128;
                att2::unit(Qs, Qs + (size_t)KVROWS * 128, Ks, Ks + (size_t)KVROWS * 128, Vs, Vs + (size_t)KVROWS * 128,
                           (unsigned short*)(ws + WS_X2) + ((size_t)b_ * 4096 + 128 * qb) * 2048 + h_ * 256, lam, 16 + 128 * qb, 2 * qb + 3, lds);
            } else {
                const int it = 2 * q3 + (t3 >> 1);
                if (tid == 0) { while (__hip_atomic_load(done + 16 * (it >> 5), __ATOMIC_RELAXED, __HIP_MEMORY_SCOPE_AGENT) < 2u) __builtin_amdgcn_s_sleep(2);
                    __builtin_amdgcn_fence(__ATOMIC_ACQUIRE, "agent"); asm volatile("s_waitcnt vmcnt(0)" ::: "memory"); }
                __syncthreads();
                ret_out_item(it, ws, lds, lds3);
            }
            DEQUEUE(idx);
        }
#undef DEQUEUE
    }
    GRID_BAR();
    {   pg8::Gemm g{(const pb*)(ws + WS_X2), (const pb*)(ws + WS_WCAT), MTOK, DM, DM}; pg8::StaticOrder S; S.init(MTOK, DM, G, (int)blockIdx.x);
        pg8::EpiMerge E{(const pb*)(ws + WS_GA), (const pb*)(ws + WS_GR), (pb*)(ws + WS_MERGED)};
        pg8::gemm_phase<pg8::EpiMerge, pg8::StaticOrder, false, true>(lds3, g, S, E); }
    GRID_BAR();
    {
        const bool conv_first = !((blockIdx.x >> 3) & 1);
        if (conv_first) convert_mlp_weights(P, lds3);
        {   pg8::Gemm g{(const pb*)(ws + WS_MERGED), (const pb*)(ws + WS_WO), MTOK, DM, DM}; pg8::StaticOrder S; S.init(MTOK, DM, G, (int)blockIdx.x);
            pg8::EpiResid<false> E{(const void*)P.x, (pb*)(ws + WS_H1B), (float*)(ws + WS_SS1)};
            pg8::gemm_phase<pg8::EpiResid<false>, pg8::StaticOrder, false, true>(lds3, g, S, E); }
        if (!conv_first) convert_mlp_weights(P, lds3); }
    GRID_BAR();
    {   pg8::Gemm g{(const pb*)(ws + WS_H1B), (const pb*)(ws + WS_WUP), MTOK, DFF, DM}; pg8::StaticOrder S; S.init(MTOK, DFF, G, (int)blockIdx.x);
        pg8::EpiUp E{(const float*)(ws + WS_SS1), (pb*)(ws + WS_HID)};
        pg8::gemm_phase<pg8::EpiUp, pg8::StaticOrder, false, true>(lds3, g, S, E); }
    GRID_BAR();
    {   pg8::Gemm g{(const pb*)(ws + WS_HID), (const pb*)(ws + WS_WDN), MTOK, DM, DFF}; pg8::StaticOrder S; S.init(MTOK, DM, G, (int)blockIdx.x);
        pg8::EpiResid<true> E{(const void*)(ws + WS_H1B), (pb*)(ws + WS_H2B), (float*)(ws + WS_SS2)};
        pg8::gemm_phase<pg8::EpiResid<true>, pg8::StaticOrder, false, true>(lds3, g, S, E); }
    GRID_BAR();
    { PHASE_IDS(); final_norm(P, gw, NGW, lane); }
}

extern "C" void kernel_launch(void* const* d_in, const int* in_sizes, int n_in, void* d_out, int out_size, void* d_ws, size_t ws_size, hipStream_t stream) {
    static int grid_blocks = 0;
    if (!grid_blocks) {
        if (n_in != 16 || in_sizes[0] != MTOK * DM || out_size != MTOK * DM || ws_size < WS_END) { fprintf(stderr, "kernel_launch: unexpected shapes (n_in %d, in0 %d, out %d, ws %zu)\n", n_in, n_in > 0 ? in_sizes[0] : -1, out_size, ws_size); grid_blocks = -1; return; }
        int dev = 0, cus = 0, per_cu = 0;
        (void)hipGetDevice(&dev);
        (void)hipDeviceGetAttribute(&cus, hipDeviceAttributeMultiprocessorCount, dev);
        (void)hipFuncSetAttribute((const void*)mega, hipFuncAttributeMaxDynamicSharedMemorySize, LDS_BYTES);
        (void)hipOccupancyMaxActiveBlocksPerMultiprocessor(&per_cu, (const void*)mega, 512, LDS_BYTES);
        if (per_cu < 1) per_cu = 1;
        grid_blocks = cus * per_cu;
    }
    if (grid_blocks < 0) return;
    (void)hipMemsetAsync((char*)d_ws + WS_CTL, 0, 65536, stream);
    Params p{};
    p.x = (const float*)d_in[0]; p.meta = (const float*)d_in[1]; p.g1 = (const float*)d_in[2]; p.w_in = (const float*)d_in[3];
    p.lq1 = (const float*)d_in[4]; p.lk1 = (const float*)d_in[5]; p.lq2 = (const float*)d_in[6]; p.lk2 = (const float*)d_in[7];
    p.subg = (const float*)d_in[8]; p.w_pa = (const float*)d_in[9]; p.w_pr = (const float*)d_in[10]; p.w_o = (const float*)d_in[11];
    p.g2 = (const float*)d_in[12]; p.w_up = (const float*)d_in[13]; p.w_dn = (const float*)d_in[14]; p.gf = (const float*)d_in[15];
    p.out = (float*)d_out; p.ws = (unsigned char*)d_ws;
    void* args[] = {&p};
    hipError_t e = hipLaunchCooperativeKernel((const void*)mega, dim3(grid_blocks), dim3(512), args, LDS_BYTES, stream);
    if (e != hipSuccess) fprintf(stderr, "cooperative launch failed: %s (grid %d)\n", hipGetErrorString(e), grid_blocks);
}
```
